# Optimizing an MI355X kernel written in HIP

```python
import jax, jax.numpy as jnp
from jax import lax
import numpy as np

D_MODEL = 1024
BATCH = 8
SEQ = 2048
DEPTH = 2

CHUNK = 64
N_MEM = 256
HEAD_DIM = 64
MIX_WIDTH = D_MODEL
N_MEM_HEADS = 4
MEM_WIDTH = N_MEM_HEADS * HEAD_DIM
TOK_WIDTH = MIX_WIDTH - MEM_WIDTH
N_FOX_HEADS = TOK_WIDTH // HEAD_DIM
GMLP_BLOCK = 128
GMLP_GROUPS = 4
GMLP_GROUP_WIDTH = TOK_WIDTH // GMLP_GROUPS
D_FF = 2816
CONV_WIDTH = 3
Q_BLOCK = 128
N_A = DEPTH // 2
N_B = DEPTH - N_A
EPS = 1e-6

kernel_name = "yoco_gmlp_fox_hybrid"


def rmsnorm(x, g):
    xf = x.astype(jnp.float32)
    y = xf * lax.rsqrt(jnp.mean(xf * xf, axis=-1, keepdims=True) + EPS)
    return (y * g.astype(jnp.float32)).astype(x.dtype)


def memory_attention(q_mem, mem, mem_norm, w_mem_kv):
    b, s = q_mem.shape[:2]
    kv = rmsnorm(mem, mem_norm) @ w_mem_kv
    k = kv[..., :MEM_WIDTH].reshape(b, N_MEM, N_MEM_HEADS, HEAD_DIM)
    v = kv[..., MEM_WIDTH:].reshape(b, N_MEM, N_MEM_HEADS, HEAD_DIM)
    q = q_mem.reshape(b, s, N_MEM_HEADS, HEAD_DIM)
    logits = jnp.einsum("bqhd,bkhd->bhqk", q, k).astype(jnp.float32) * (HEAD_DIM ** -0.5)
    p = jax.nn.softmax(logits, axis=-1).astype(v.dtype)
    o = jnp.einsum("bhqk,bkhd->bqhd", p, v)
    return o.reshape(b, s, MEM_WIDTH)


def gmlp_spatial_gating(u, v, v_norm, w_s, b_s):
    b, s, _ = v.shape
    n = s // GMLP_BLOCK
    vn = rmsnorm(v, v_norm).reshape(b, n, GMLP_BLOCK, GMLP_GROUPS, GMLP_GROUP_WIDTH)
    causal = jnp.tril(jnp.ones((GMLP_BLOCK, GMLP_BLOCK), dtype=bool))
    w = jnp.where(causal[None], w_s, jnp.zeros_like(w_s))
    mixed = jnp.einsum("gts,bnsgc->bntgc", w, vn) + b_s.T[None, None, :, :, None]
    return u * mixed.reshape(b, s, TOK_WIDTH)


def forgetting_attention(q, k, v, log_f_cum):
    s = q.shape[1]
    scale = HEAD_DIM ** -0.5
    c = jnp.transpose(log_f_cum, (0, 2, 1))
    outs = []
    for i in range(s // Q_BLOCK):
        q0, q1 = i * Q_BLOCK, (i + 1) * Q_BLOCK
        logits = jnp.einsum("bqhd,bkhd->bhqk", q[:, q0:q1], k[:, :q1]).astype(jnp.float32) * scale
        decay = c[:, :, q0:q1, None] - c[:, :, None, :q1]
        qpos = jnp.arange(q0, q1)[:, None]
        kpos = jnp.arange(q1)[None, :]
        logits = jnp.where(qpos >= kpos, logits + decay, -jnp.inf)
        p = jax.nn.softmax(logits, axis=-1).astype(v.dtype)
        outs.append(jnp.einsum("bhqk,bkhd->bqhd", p, v[:, :q1]))
    return jnp.concatenate(outs, axis=1)


def conv_ffn(x, w_in, conv_w, conv_b, w_out):
    s = x.shape[1]
    h = x @ w_in
    hp = jnp.pad(h, ((0, 0), (CONV_WIDTH - 1, 0), (0, 0)))
    hc = conv_b + conv_w[CONV_WIDTH - 1] * h
    for j in range(CONV_WIDTH - 1):
        hc = hc + conv_w[j] * hp[:, j:j + s]
    gate, up = hc[..., :D_FF], hc[..., D_FF:]
    return (jax.nn.silu(gate) * up) @ w_out


def setup_inputs(seed: int = 0) -> dict:
    key = jax.random.key(seed)
    ks = iter(jax.random.split(key, 64))

    def nrm(shape, scale):
        return jax.random.normal(next(ks), shape, jnp.float32) * scale

    def gain(shape):
        return 1.0 + nrm(shape, 0.05)

    D = D_MODEL
    inv = D ** -0.5
    inp = {}
    inp["x"] = nrm((BATCH, SEQ, D), 1.0)
    inp["mem"] = nrm((BATCH, N_MEM, D), 1.0)
    inp["a_norm1"] = gain((N_A, D))
    inp["a_w_in"] = nrm((N_A, D, 2 * TOK_WIDTH + MEM_WIDTH), inv)
    inp["a_v_norm"] = gain((N_A, TOK_WIDTH))
    inp["a_w_s"] = nrm((N_A, GMLP_GROUPS, GMLP_BLOCK, GMLP_BLOCK), 0.5 * GMLP_BLOCK ** -0.5)
    inp["a_b_s"] = 1.0 + nrm((N_A, GMLP_GROUPS, GMLP_BLOCK), 0.1)
    inp["a_mem_norm"] = gain((N_A, D))
    inp["a_w_mem_kv"] = nrm((N_A, D, 2 * MEM_WIDTH), inv)
    inp["a_w_out"] = nrm((N_A, MIX_WIDTH, D), MIX_WIDTH ** -0.5)
    inp["a_norm2"] = gain((N_A, D))
    inp["a_ffn_in"] = nrm((N_A, D, 2 * D_FF), inv)
    inp["a_ffn_conv"] = nrm((N_A, CONV_WIDTH, 2 * D_FF), CONV_WIDTH ** -0.5)
    inp["a_ffn_conv_b"] = nrm((N_A, 2 * D_FF), 0.02)
    inp["a_ffn_out"] = nrm((N_A, D_FF, D), D_FF ** -0.5)
    inp["kv_norm"] = gain((D,))
    inp["w_kv"] = nrm((D, 2 * TOK_WIDTH + N_FOX_HEADS), inv)
    inp["b_f"] = jax.random.uniform(next(ks), (N_FOX_HEADS,), jnp.float32, 1.0, 6.0)
    inp["b_norm1"] = gain((N_B, D))
    inp["b_w_q"] = nrm((N_B, D, TOK_WIDTH + MEM_WIDTH), inv)
    inp["b_mem_norm"] = gain((N_B, D))
    inp["b_w_mem_kv"] = nrm((N_B, D, 2 * MEM_WIDTH), inv)
    inp["b_w_out"] = nrm((N_B, MIX_WIDTH, D), MIX_WIDTH ** -0.5)
    inp["b_norm2"] = gain((N_B, D))
    inp["b_ffn_in"] = nrm((N_B, D, 2 * D_FF), inv)
    inp["b_ffn_conv"] = nrm((N_B, CONV_WIDTH, 2 * D_FF), CONV_WIDTH ** -0.5)
    inp["b_ffn_conv_b"] = nrm((N_B, 2 * D_FF), 0.02)
    inp["b_ffn_out"] = nrm((N_B, D_FF, D), D_FF ** -0.5)
    inp["final_norm"] = gain((D,))
    return inp


def reference(x, mem,
              a_norm1, a_w_in, a_v_norm, a_w_s, a_b_s, a_mem_norm, a_w_mem_kv, a_w_out,
              a_norm2, a_ffn_in, a_ffn_conv, a_ffn_conv_b, a_ffn_out,
              kv_norm, w_kv, b_f,
              b_norm1, b_w_q, b_mem_norm, b_w_mem_kv, b_w_out,
              b_norm2, b_ffn_in, b_ffn_conv, b_ffn_conv_b, b_ffn_out,
              final_norm):
    b, s, _ = x.shape
    k_sh = v_sh = log_f_cum = None
    for layer in range(DEPTH):
        if layer < N_A:
            i = layer
            h = rmsnorm(x, a_norm1[i])
            z = h @ a_w_in[i]
            u = jax.nn.gelu(z[..., :TOK_WIDTH])
            vv = jax.nn.gelu(z[..., TOK_WIDTH:2 * TOK_WIDTH])
            q_mem = z[..., 2 * TOK_WIDTH:]
            tok = gmlp_spatial_gating(u, vv, a_v_norm[i], a_w_s[i], a_b_s[i])
            mem_o = memory_attention(q_mem, mem, a_mem_norm[i], a_w_mem_kv[i])
            x = x + jnp.concatenate([tok, mem_o], axis=-1) @ a_w_out[i]
            x = x + conv_ffn(rmsnorm(x, a_norm2[i]), a_ffn_in[i], a_ffn_conv[i], a_ffn_conv_b[i], a_ffn_out[i])
            if layer == N_A - 1:
                kvf = rmsnorm(x, kv_norm) @ w_kv
                k_sh = kvf[..., :TOK_WIDTH].reshape(b, s, N_FOX_HEADS, HEAD_DIM)
                v_sh = kvf[..., TOK_WIDTH:2 * TOK_WIDTH].reshape(b, s, N_FOX_HEADS, HEAD_DIM)
                f_logit = kvf[..., 2 * TOK_WIDTH:].astype(jnp.float32) + b_f.astype(jnp.float32)
                log_f_cum = jnp.cumsum(jax.nn.log_sigmoid(f_logit), axis=1)
        else:
            j = layer - N_A
            h = rmsnorm(x, b_norm1[j])
            z = h @ b_w_q[j]
            q = z[..., :TOK_WIDTH].reshape(b, s, N_FOX_HEADS, HEAD_DIM)
            q_mem = z[..., TOK_WIDTH:]
            tok = forgetting_attention(q, k_sh, v_sh, log_f_cum).reshape(b, s, TOK_WIDTH)
            mem_o = memory_attention(q_mem, mem, b_mem_norm[j], b_w_mem_kv[j])
            x = x + jnp.concatenate([tok, mem_o], axis=-1) @ b_w_out[j]
            x = x + conv_ffn(rmsnorm(x, b_norm2[j]), b_ffn_in[j], b_ffn_conv[j], b_ffn_conv_b[j], b_ffn_out[j])
    return rmsnorm(x, final_norm)
```

```cpp
#include <hip/hip_runtime.h>
#include <cstdio>
#include <cstdint>

namespace nv {
constexpr int D = 1024, S = 2048, NB = 8, NMEM = 256, TOK = 768, MEMW = 256, DFF = 2816, NFOX = 12;
constexpr float EPS = 1e-6f;

__device__ __forceinline__ float wave_sum(float v) {
#pragma unroll
    for (int o = 1; o < 64; o <<= 1) v += __shfl_xor(v, o);
    return v;
}
__device__ __forceinline__ float gelu_tanh(float x) {
    const float u = 0.7978845608028654f * (x + 0.044715f * x * x * x);
    return x / (1.0f + __expf(-2.0f * u));
}
__device__ __forceinline__ float log_sigmoid(float x) {
    return x >= 0.f ? -log1pf(__expf(-x)) : x - log1pf(__expf(x));
}

__global__ void k_rmsnorm(const float* x, const float* g, float* out, int rows, int ncols) {
    const int row = blockIdx.x * 4 + (threadIdx.x >> 6), lane = threadIdx.x & 63;
    if (row >= rows) return;
    const float* xr = x + (size_t)row * ncols;
    float v[16]; float s = 0.f;
#pragma unroll
    for (int j = 0; j < 16; ++j) { const int c = lane + 64 * j; v[j] = c < ncols ? xr[c] : 0.f; s += v[j] * v[j]; }
    s = wave_sum(s);
    const float r = rsqrtf(s / (float)ncols + EPS);
#pragma unroll
    for (int j = 0; j < 16; ++j) { const int c = lane + 64 * j; if (c < ncols) out[(size_t)row * ncols + c] = v[j] * r * g[c]; }
}

template <bool RES>
__global__ void __launch_bounds__(256) k_gemm(const float* __restrict__ A, int lda, const float* __restrict__ W, int ldw, float* C, int ldc,
                                              const float* R, int ldr, int M, int N, int K) {
    __shared__ float As[16][68];
    __shared__ float Bs[16][68];
    const int t = threadIdx.x, tx = t & 15, ty = t >> 4;
    const int m0 = blockIdx.y * 64, n0 = blockIdx.x * 64;
    float acc[4][4];
#pragma unroll
    for (int i = 0; i < 4; ++i)
#pragma unroll
        for (int j = 0; j < 4; ++j) acc[i][j] = 0.f;
    const int am = t >> 2, ak = (t & 3) * 4;
    const int bk = t >> 4, bn = (t & 15) * 4;
    for (int k0 = 0; k0 < K; k0 += 16) {
        const float4 av = *(const float4*)(A + (size_t)(m0 + am) * lda + k0 + ak);
        float4 bv = make_float4(0.f, 0.f, 0.f, 0.f);
        if (n0 + bn < N) bv = *(const float4*)(W + (size_t)(k0 + bk) * ldw + n0 + bn);
        __syncthreads();
        As[ak + 0][am] = av.x; As[ak + 1][am] = av.y; As[ak + 2][am] = av.z; As[ak + 3][am] = av.w;
        *(float4*)&Bs[bk][bn] = bv;
        __syncthreads();
#pragma unroll
        for (int k = 0; k < 16; ++k) {
            const float4 a = *(const float4*)&As[k][ty * 4];
            const float4 b = *(const float4*)&Bs[k][tx * 4];
            const float aa[4] = {a.x, a.y, a.z, a.w}, bb[4] = {b.x, b.y, b.z, b.w};
#pragma unroll
            for (int i = 0; i < 4; ++i)
#pragma unroll
                for (int j = 0; j < 4; ++j) acc[i][j] = fmaf(aa[i], bb[j], acc[i][j]);
        }
    }
#pragma unroll
    for (int i = 0; i < 4; ++i) {
        const int m = m0 + ty * 4 + i;
#pragma unroll
        for (int j = 0; j < 4; ++j) {
            const int n = n0 + tx * 4 + j;
            if (n < N) { float v = acc[i][j]; if (RES) v += R[(size_t)m * ldr + n]; C[(size_t)m * ldc + n] = v; }
        }
    }
}

__global__ void k_vnorm(const float* z, const float* g, float* vn, int rows) {
    const int row = blockIdx.x * 4 + (threadIdx.x >> 6), lane = threadIdx.x & 63;
    if (row >= rows) return;
    float v[12]; float s = 0.f;
#pragma unroll
    for (int j = 0; j < 12; ++j) { v[j] = gelu_tanh(z[(size_t)row * 1792 + TOK + lane + 64 * j]); s += v[j] * v[j]; }
    s = wave_sum(s);
    const float r = rsqrtf(s / (float)TOK + EPS);
#pragma unroll
    for (int j = 0; j < 12; ++j) vn[(size_t)row * TOK + lane + 64 * j] = v[j] * r * g[lane + 64 * j];
}

__global__ void k_gating(const float* z, const float* vn, const float* w_s, const float* b_s, float* mix) {
    const int t = blockIdx.y, gc = blockIdx.x * 256 + threadIdx.x;
    const int g = gc / 192, tt = t & 127, s0 = t - tt;
    const float* w = w_s + ((size_t)g * 128 + tt) * 128;
    float acc = 0.f;
    for (int ss = 0; ss <= tt; ++ss) acc = fmaf(w[ss], vn[(size_t)(s0 + ss) * TOK + gc], acc);
    acc += b_s[g * 128 + tt];
    mix[(size_t)t * D + gc] = gelu_tanh(z[(size_t)t * 1792 + gc]) * acc;
}

__global__ void k_memattn(const float* zq, int ldq, int qoff, const float* memkv, float* mix) {
    const int row = blockIdx.x, h = threadIdx.x >> 6, lane = threadIdx.x & 63;
    const float q = zq[(size_t)row * ldq + qoff + 64 * h + lane] * 0.125f;
    float m = -INFINITY, l = 0.f, acc = 0.f;
    for (int j = 0; j < NMEM; ++j) {
        const float s = wave_sum(q * memkv[(size_t)j * 512 + 64 * h + lane]);
        const float mn = fmaxf(m, s), a = __expf(m - mn), p = __expf(s - mn);
        l = l * a + p; acc = acc * a + p * memkv[(size_t)j * 512 + 256 + 64 * h + lane]; m = mn;
    }
    mix[(size_t)row * D + TOK + 64 * h + lane] = acc / l;
}

__global__ void k_cumsum(const float* kvf, const float* b_f, float* c) {
    const int h = threadIdx.x;
    if (h >= NFOX) return;
    float acc = 0.f; const float bf = b_f[h];
    for (int t = 0; t < S; ++t) { acc += log_sigmoid(kvf[(size_t)t * 1548 + 1536 + h] + bf); c[h * S + t] = acc; }
}

__global__ void __launch_bounds__(768) k_foxattn(const float* qz, const float* kvf, const float* c, float* mix) {
    const int t = blockIdx.x, h = threadIdx.x >> 6, lane = threadIdx.x & 63;
    const float q = qz[(size_t)t * D + 64 * h + lane] * 0.125f;
    const float ct = c[h * S + t];
    float m = -INFINITY, l = 0.f, acc = 0.f;
    for (int j = 0; j <= t; ++j) {
        const float s = wave_sum(q * kvf[(size_t)j * 1548 + 64 * h + lane]) + (ct - c[h * S + j]);
        const float mn = fmaxf(m, s), a = __expf(m - mn), p = __expf(s - mn);
        l = l * a + p; acc = acc * a + p * kvf[(size_t)j * 1548 + TOK + 64 * h + lane]; m = mn;
    }
    mix[(size_t)t * D + 64 * h + lane] = acc / l;
}

__global__ void k_convgate(const float* h, const float* cw, const float* cb, float* g) {
    const int t = blockIdx.y, j = blockIdx.x * 256 + threadIdx.x;
    float hc[2];
#pragma unroll
    for (int p = 0; p < 2; ++p) {
        const int col = j + p * DFF;
        float v = cb[col] + cw[2 * 5632 + col] * h[(size_t)t * 5632 + col];
        if (t >= 1) v += cw[1 * 5632 + col] * h[(size_t)(t - 1) * 5632 + col];
        if (t >= 2) v += cw[0 * 5632 + col] * h[(size_t)(t - 2) * 5632 + col];
        hc[p] = v;
    }
    g[(size_t)t * DFF + j] = hc[0] / (1.0f + __expf(-hc[0])) * hc[1];
}
}

extern "C" void kernel_launch(void* const* d_in, const int* in_sizes, int n_in, void* d_out, int out_size, void* d_ws, size_t ws_size, hipStream_t stream) {
    using namespace nv;
    const float* const* in = (const float* const*)d_in;
    const float* x = in[0]; const float* mem = in[1];
    float* out = (float*)d_out;
    char* ws = (char*)d_ws;
    size_t off = 0;
    auto carve = [&](size_t bytes) { float* p = (float*)(ws + off); off += (bytes + 255) & ~(size_t)255; return p; };
    float* xn = carve((size_t)S * D * 4);
    float* z = carve((size_t)S * 1792 * 4);
    float* vn = carve((size_t)S * TOK * 4);
    float* mix = carve((size_t)S * D * 4);
    float* hbuf = carve((size_t)S * 5632 * 4);
    float* gbuf = carve((size_t)S * DFF * 4);
    float* memn = carve((size_t)NMEM * D * 4);
    float* memkv = carve((size_t)NMEM * 512 * 4);
    float* kvf = carve((size_t)S * 1548 * 4);
    float* qz = carve((size_t)S * D * 4);
    float* cf = carve((size_t)NFOX * S * 4);
    if (off > ws_size) { fprintf(stderr, "ws too small\n"); return; }

    auto gemm = [&](const float* A, int lda, const float* W, int N, int K, float* C, int ldc, const float* R, int ldr, int M) {
        dim3 grid((N + 63) / 64, M / 64);
        if (R) hipLaunchKernelGGL(k_gemm<true>, grid, dim3(256), 0, stream, A, lda, W, N, C, ldc, R, ldr, M, N, K);
        else hipLaunchKernelGGL(k_gemm<false>, grid, dim3(256), 0, stream, A, lda, W, N, C, ldc, R, ldr, M, N, K);
    };
    auto rms = [&](const float* xi, const float* g, float* o, int rows, int ncols) {
        hipLaunchKernelGGL(k_rmsnorm, dim3((rows + 3) / 4), dim3(256), 0, stream, xi, g, o, rows, ncols);
    };
    auto ffn = [&](float* xc, const float* norm, const float* w_in, const float* cw, const float* cb, const float* w_out) {
        rms(xc, norm, xn, S, D);
        gemm(xn, D, w_in, 5632, D, hbuf, 5632, nullptr, 0, S);
        hipLaunchKernelGGL(k_convgate, dim3(DFF / 256, S), dim3(256), 0, stream, hbuf, cw, cb, gbuf);
        gemm(gbuf, DFF, w_out, D, DFF, xc, D, xc, D, S);
    };
    for (int b = 0; b < NB; ++b) {
        const float* xin = x + (size_t)b * S * D; float* xc = out + (size_t)b * S * D; const float* memb = mem + (size_t)b * NMEM * D;
        rms(xin, in[2], xn, S, D);
        gemm(xn, D, in[3], 1792, D, z, 1792, nullptr, 0, S);
        rms(memb, in[7], memn, NMEM, D);
        gemm(memn, D, in[8], 512, D, memkv, 512, nullptr, 0, NMEM);
        hipLaunchKernelGGL(k_vnorm, dim3(S / 4), dim3(256), 0, stream, z, in[4], vn, S);
        hipLaunchKernelGGL(k_gating, dim3(TOK / 256, S), dim3(256), 0, stream, z, vn, in[5], in[6], mix);
        hipLaunchKernelGGL(k_memattn, dim3(S), dim3(256), 0, stream, z, 1792, 1536, memkv, mix);
        gemm(mix, D, in[9], D, D, xc, D, xin, D, S);
        ffn(xc, in[10], in[11], in[12], in[13], in[14]);
        rms(xc, in[15], xn, S, D);
        gemm(xn, D, in[16], 1548, D, kvf, 1548, nullptr, 0, S);
        hipLaunchKernelGGL(k_cumsum, dim3(1), dim3(64), 0, stream, kvf, in[17], cf);
        rms(xc, in[18], xn, S, D);
        gemm(xn, D, in[19], D, D, qz, D, nullptr, 0, S);
        hipLaunchKernelGGL(k_foxattn, dim3(S), dim3(768), 0, stream, qz, kvf, cf, mix);
        rms(memb, in[20], memn, NMEM, D);
        gemm(memn, D, in[21], 512, D, memkv, 512, nullptr, 0, NMEM);
        hipLaunchKernelGGL(k_memattn, dim3(S), dim3(256), 0, stream, qz, D, TOK, memkv, mix);
        gemm(mix, D, in[22], D, D, xc, D, xc, D, S);
        ffn(xc, in[23], in[24], in[25], in[26], in[27]);
        rms(xc, in[28], xc, S, D);
    }
}
```

```cpp
#define MK_N_LAUNCHES 14
#include <hip/hip_runtime.h>
#include <hip/hip_bf16.h>
#include <cstdio>
#include <cstdint>
#include <cmath>

#define LAS __attribute__((address_space(3)))
#define GAS __attribute__((address_space(1)))
typedef unsigned short bf16_t;
typedef short bf16x8 __attribute__((ext_vector_type(8)));
typedef float f32x4 __attribute__((ext_vector_type(4)));
typedef float f32x2 __attribute__((ext_vector_type(2)));
typedef float f32x16 __attribute__((ext_vector_type(16)));
typedef unsigned u32x4 __attribute__((ext_vector_type(4)));
typedef unsigned u32x2 __attribute__((ext_vector_type(2)));
typedef short s16x4 __attribute__((ext_vector_type(4)));

constexpr int NB = 8, SEQ = 2048, D = 1024, M = NB * SEQ, NMEM = 256, MROWS = NB * NMEM;
constexpr int TOK = 768, MEMW = 256, DFF = 2816, NFOX = 12, ZW = 1792, KVW = 768;
constexpr float EPS = 1e-6f;
constexpr float LOG2E = 1.4426950408889634f;
constexpr float C2 = 0.125f * LOG2E;
constexpr int NWAVES = 8, NTHR = 512;

constexpr size_t MiB = 1u << 20;
constexpr size_t WS_CTL = 0, CTL_ZERO_BYTES = 64 * 1024;
constexpr size_t WS_WIN = 1 * MiB;
constexpr size_t WS_WMEM = 5 * MiB;
constexpr size_t WS_AWOUT = 7 * MiB;
constexpr size_t WS_AFFI = 9 * MiB;
constexpr size_t WS_AFFO = 20 * MiB;
constexpr size_t WS_KVQ = 26 * MiB;
constexpr size_t WS_BWOUT = 32 * MiB;
constexpr size_t WS_BFFI = 34 * MiB;
constexpr size_t WS_BFFO = 45 * MiB;
constexpr size_t WS_XB = 51 * MiB;
constexpr size_t WS_MIX = 83 * MiB;
constexpr size_t WS_MEMB = 115 * MiB;
constexpr size_t WS_MEMKV = 119 * MiB;
constexpr size_t WS_SS4 = 123 * MiB;
constexpr size_t WS_MEMSS = 123 * MiB + 256 * 1024;
constexpr size_t WS_VSSP = 123 * MiB + 512 * 1024;
constexpr size_t WS_LF = 124 * MiB + 512 * 1024;
constexpr size_t WS_HALO = 126 * MiB;
constexpr size_t WS_R1 = 137 * MiB;
constexpr size_t WS_KB = WS_R1, WS_VB = WS_R1 + 24 * MiB, WS_QB = WS_R1 + 48 * MiB;
constexpr size_t WS_QMEM = 225 * MiB;
constexpr size_t WS_END = 233 * MiB;

constexpr int RING_BYTES = 131072;
constexpr int MISC_OFF = RING_BYTES;
constexpr int LDS_BYTES = 147456;

#define RLX_AGENT __ATOMIC_RELAXED, __HIP_MEMORY_SCOPE_AGENT
__device__ __forceinline__ unsigned f2bf(float f) { unsigned u = __builtin_bit_cast(unsigned, f); return (u + 0x7fffu + ((u >> 16) & 1u)) >> 16; }
__device__ __forceinline__ unsigned pk2(float lo, float hi) {
    typedef __bf16 bf2 __attribute__((ext_vector_type(2)));
    f32x2 v = {lo, hi}; bf2 b = __builtin_convertvector(v, bf2); return __builtin_bit_cast(unsigned, b); }
__device__ __forceinline__ float bf_lo(unsigned u) { return __builtin_bit_cast(float, u << 16); }
__device__ __forceinline__ float bf_hi(unsigned u) { return __builtin_bit_cast(float, u & 0xffff0000u); }
__device__ __forceinline__ float wave_sum(float v) {
#pragma unroll
    for (int o = 1; o < 64; o <<= 1) v += __shfl_xor(v, o);
    return v;
}
__device__ __forceinline__ float gelu_tanh(float x) {
    const float u = x * (0.7978845608028654f + 0.035677408136300125f * x * x);
    return x * __builtin_amdgcn_rcpf(1.0f + __builtin_amdgcn_exp2f(-2.0f * LOG2E * u));
}
__device__ __forceinline__ float silu_f(float x) { return x * __builtin_amdgcn_rcpf(1.0f + __builtin_amdgcn_exp2f(-LOG2E * x)); }
__device__ __forceinline__ float log_sigmoid_f(float x) { return x >= 0.f ? -log1pf(__expf(-x)) : x - log1pf(__expf(x)); }

#define XB_TMO      128
#define XB_XCNT(j)  (256  + 64 * (j))
#define XB_XSUB(j)  (1280 + 64 * (j))
#define XB_XGEN(j)  (2304 + 64 * (j))
#define XB_TOP      3328
#define XB_TOPGEN   3392
#define XCD_BAR_WORDS 3456
#define XB_SPIN_CAP (1u << 18)
__device__ __forceinline__ unsigned xb_ld(unsigned* p)              { return __hip_atomic_load(p, __ATOMIC_RELAXED, __HIP_MEMORY_SCOPE_AGENT); }
__device__ __forceinline__ unsigned xb_add(unsigned* p, unsigned v) { return __hip_atomic_fetch_add(p, v, __ATOMIC_RELAXED, __HIP_MEMORY_SCOPE_AGENT); }
__device__ __forceinline__ unsigned xb_xcc_id() { return (unsigned)__builtin_amdgcn_s_getreg((3 << 11) | 20) & 0xFu; }
#define XB_SPIN(cond, bar) do { unsigned _sp = 0; while (cond) { __builtin_amdgcn_s_sleep(1); \
    if ((++_sp & 255u) == 0u) { if (xb_ld(&(bar)[XB_TMO])) break; if (_sp > XB_SPIN_CAP) { atomicAdd(&(bar)[XB_TMO], 1u); break; } } } } while (0)
struct XcdBarrier { unsigned* bar; unsigned x; volatile LAS unsigned* st; };
__device__ __forceinline__ XcdBarrier xcd_barrier_post(unsigned* bar, volatile LAS unsigned* st) {
    XcdBarrier b; b.bar = bar; b.x = xb_xcc_id(); b.st = st;
    if (threadIdx.x == 0) (void)xb_add(&bar[XB_XCNT(b.x)], 1u);
    return b;
}
__device__ __forceinline__ void xcd_barrier_complete(unsigned* bar, unsigned x, unsigned& nloc, unsigned& nx) {
    const unsigned G = gridDim.x * gridDim.y * gridDim.z;
    unsigned sum, cnt, mine, sp = 0u;
    for (;;) {
        sum = 0u; cnt = 0u; mine = 0u;
#pragma unroll
        for (unsigned j = 0; j < 16; ++j) { const unsigned c = xb_ld(&bar[XB_XCNT(j)]); sum += c; cnt += (c > 0u) ? 1u : 0u; mine = (j == x) ? c : mine; }
        if (sum == G) break;
        __builtin_amdgcn_s_sleep(1);
        if ((++sp & 255u) == 0u) { if (xb_ld(&bar[XB_TMO])) break; if (sp > XB_SPIN_CAP) { atomicAdd(&bar[XB_TMO], 1u); break; } }
    }
    nloc = mine > 0u ? mine : 1u; nx = cnt > 0u ? cnt : 1u;
}
__device__ __forceinline__ void xcd_barrier(const XcdBarrier& b) {
    asm volatile("s_waitcnt vmcnt(0)" ::: "memory");
    __syncthreads();
    if (threadIdx.x == 0) {
        unsigned* bar = b.bar;
        __builtin_amdgcn_s_waitcnt(0);
        unsigned nloc = b.st[0], nx = b.st[1];
        if (nloc == 0u) { xcd_barrier_complete(bar, b.x, nloc, nx); b.st[0] = nloc; b.st[1] = nx; }
        const unsigned old = xb_add(&bar[XB_XSUB(b.x)], 1u);
        const unsigned gen = old / nloc;
        if (old + 1u == (gen + 1u) * nloc) {
            __builtin_amdgcn_fence(__ATOMIC_RELEASE, "agent");
            asm volatile("s_waitcnt vmcnt(0)" ::: "memory");
            const unsigned og = xb_add(&bar[XB_TOP], 1u);
            const unsigned tg = og / nx;
            if (og + 1u == (tg + 1u) * nx) xb_add(&bar[XB_TOPGEN], 1u);
            else XB_SPIN(xb_ld(&bar[XB_TOPGEN]) == tg, bar);
            __builtin_amdgcn_fence(__ATOMIC_ACQUIRE, "agent");
            xb_add(&bar[XB_XGEN(b.x)], 1u);
            asm volatile("s_waitcnt vmcnt(0)" ::: "memory");
        } else {
            XB_SPIN(xb_ld(&bar[XB_XGEN(b.x)]) == gen, bar);
            __builtin_amdgcn_fence(__ATOMIC_ACQUIRE, "agent");
            asm volatile("s_waitcnt vmcnt(0)" ::: "memory");
        }
    }
    __syncthreads();
}

namespace pg8 {
constexpr int BM = 256, BK = 64, HALF = 128, HTB = HALF * BK * 2, STAGE_BYTES = 8 * HTB, NXCD = 8, WGM = 8;
__host__ __device__ __forceinline__ int lds_byte(int r, int c) { const int st = (r >> 4) * 2 + (c >> 5), rr = r & 15, cc = c & 31, ob = rr * 64 + cc * 2; return st * 1024 + (ob ^ (((ob >> 9) & 1) << 5)); }
__host__ __device__ __forceinline__ void stage_rc(int b, int& R, int& C) { const int st = b / 1024, sb = b % 1024, swz = sb ^ (((sb >> 9) & 1) << 5); R = (st >> 1) * 16 + swz / 64; C = (st & 1) * 32 + (swz % 64) / 2; }
__host__ __device__ __forceinline__ int perm32(int rho) { const int n = rho >> 4, i = rho & 15; return 8 * (i >> 2) + 4 * n + (i & 3); }

struct Unit { int pm, pn, kind; };
struct Sched {
    int nM, nN, nwg, G, c, K; const bf16_t* A; const bf16_t* Bt;
    int nwg2, nM2; const bf16_t* A2; const bf16_t* Bt2;
    __device__ void init(int M_, int N_, int K_, int G_, int c_, const bf16_t* A_, const bf16_t* Bt_) { nM = M_ / BM; nN = N_ / BM; nwg = nM * nN; G = G_; c = c_; K = K_; A = A_; Bt = Bt_; nwg2 = 0; nM2 = 1; A2 = A_; Bt2 = Bt_; }
    __device__ void extra(int M2, int N2, const bf16_t* A2_, const bf16_t* Bt2_) { nM2 = M2 / BM; nwg2 = nM2 * (N2 / BM); A2 = A2_; Bt2 = Bt2_; }
    __device__ bool next(int i, Unit& u) const {
        const long L = (long)i * G + c;
        if (L >= nwg) { const long e = L - nwg; if (e >= nwg2) return false; u.pm = (int)(e % nM2); u.pn = (int)(e / nM2); u.kind = 1; return true; }
        int wgid = (int)L; { const int q = nwg / NXCD, r = nwg % NXCD, xcd = wgid % NXCD, off = wgid / NXCD; wgid = (xcd < r ? xcd * (q + 1) : r * (q + 1) + (xcd - r) * q) + off; }
        const int nig = WGM * nN, gid = wgid / nig, fm = gid * WGM, gsz = (nM - fm) < WGM ? (nM - fm) : WGM;
        u.pm = fm + ((wgid % nig) % gsz); u.pn = (wgid % nig) / gsz; u.kind = 0; return true;
    }
    __device__ __forceinline__ const char* a_ptr(const Unit& u) const { return (const char*)(u.kind ? A2 : A) + (size_t)u.pm * BM * K * 2; }
    __device__ __forceinline__ const char* b_ptr(const Unit& u) const { return (const char*)(u.kind ? Bt2 : Bt) + (size_t)u.pn * BM * K * 2; }
};

template <class Epi, bool ALIGN_EPI, bool A_PERM>
__device__ __forceinline__ void gemm_phase(LAS unsigned char* lds, const Sched& S, const Epi& E) {
    int tid = threadIdx.x; asm volatile("" : "+v"(tid));
    const int wid = __builtin_amdgcn_readfirstlane(tid >> 6), lane = tid & 63, wr = wid >> 2, wc = wid & 3, fr = lane & 15, fq = lane >> 4;
    const int K = S.K, nt = K / BK;
    unsigned voffA[2], voffB[2];
#pragma unroll
    for (int i = 0; i < 2; ++i) { int R, C; stage_rc(tid * 16 + i * 8192, R, C); const int Rb = (R & ~31) + perm32(R & 31);
        const int Ra = A_PERM ? (128 * (R >> 6) + 8 * (R & 15) + ((R >> 4) & 3)) : R;
        voffA[i] = (unsigned)(Ra * K + C) * 2u; voffB[i] = (unsigned)(Rb * K + C) * 2u; }
    const size_t kstep = (size_t)(BK * 2);
    const size_t hstepB = (size_t)HALF * K * 2;
    const size_t hstepA = A_PERM ? (size_t)4 * K * 2 : (size_t)HALF * K * 2;
    const unsigned ldsw = (unsigned)wid * 1024u;
    const int aoff = lds_byte(wr * 64 + fr, fq * 8), boff = lds_byte(wc * 32 + fr, fq * 8);
#define PG8_SA(b, h) (((b) * 2 + (h)) * HTB)
#define PG8_SB(b, h) ((4 + (b) * 2 + (h)) * HTB)
#define PG8_STAGE(bufoff, gbase, voff) do { _Pragma("unroll") for (int _i = 0; _i < 2; ++_i) \
        __builtin_amdgcn_global_load_lds((const unsigned*)((const char*)(gbase) + (voff)[_i]), (LAS unsigned*)(lds + (bufoff) + ldsw + _i * 8192), 16, 0, 0); } while (0)
#define PG8_LDA(dst, b, h) do { _Pragma("unroll") for (int m = 0; m < 4; ++m) _Pragma("unroll") for (int k = 0; k < 2; ++k) dst[m][k] = *(const LAS bf16x8*)(lds + PG8_SA(b, h) + aoff + m * 2048 + k * 1024); } while (0)
#define PG8_LDB(dst, b, h) do { _Pragma("unroll") for (int n = 0; n < 2; ++n) _Pragma("unroll") for (int k = 0; k < 2; ++k) dst[n][k] = *(const LAS bf16x8*)(lds + PG8_SB(b, h) + boff + n * 2048 + k * 1024); } while (0)
#define PG8_MMA(ai, bj, At, Bt) do { __builtin_amdgcn_s_setprio(1); _Pragma("unroll") for (int m = 0; m < 4; ++m) _Pragma("unroll") for (int n = 0; n < 2; ++n) _Pragma("unroll") for (int k = 0; k < 2; ++k) \
        acc[ai][bj][m][n] = __builtin_amdgcn_mfma_f32_16x16x32_bf16(Bt[n][k], At[m][k], acc[ai][bj][m][n], 0, 0, 0); __builtin_amdgcn_s_setprio(0); } while (0)
#define PG8_WAIT_V(n) asm volatile("s_waitcnt vmcnt(" #n ")" ::: "memory")
#define PG8_WAIT_L(n) asm volatile("s_waitcnt lgkmcnt(" #n ")" ::: "memory")
#define PG8_BAR __builtin_amdgcn_s_barrier()
#define PG8_SCHED __builtin_amdgcn_sched_barrier(0)
    Unit cur, nxt; int ui = 0;
    if (!S.next(0, cur)) return;
    f32x4 acc[2][2][4][2];
#pragma unroll
    for (int a = 0; a < 2; ++a)
#pragma unroll
        for (int b = 0; b < 2; ++b)
#pragma unroll
            for (int m = 0; m < 4; ++m)
#pragma unroll
                for (int n = 0; n < 2; ++n) acc[a][b][m][n] = (f32x4){0.f, 0.f, 0.f, 0.f};
    bf16x8 At[4][2], B0[2][2], B1[2][2];
    const char* cA = S.a_ptr(cur); const char* cB = S.b_ptr(cur);
    PG8_STAGE(PG8_SB(0, 0), cB, voffB); PG8_STAGE(PG8_SB(0, 1), cB + hstepB, voffB); PG8_STAGE(PG8_SA(0, 0), cA, voffA); PG8_STAGE(PG8_SA(0, 1), cA + hstepA, voffA);
    if (wr == 1) PG8_BAR;
    PG8_WAIT_V(2); PG8_BAR;
    PG8_STAGE(PG8_SB(1, 0), cB + kstep, voffB); PG8_STAGE(PG8_SA(1, 0), cA + kstep, voffA); PG8_STAGE(PG8_SB(1, 1), cB + hstepB + kstep, voffB);
    PG8_WAIT_V(6); PG8_BAR;
    for (;;) {
        const bool has_next = S.next(ui + 1, nxt);
        const char* nA = has_next ? S.a_ptr(nxt) : cA; const char* nB = has_next ? S.b_ptr(nxt) : cB;
        for (int t = 0; t < nt; t += 2) {
            const bool last = (t == nt - 2);
            const char* a1 = cA + (size_t)(t + 1) * kstep;
            const char* a2 = last ? nA : cA + (size_t)(t + 2) * kstep; const char* b2 = last ? nB : cB + (size_t)(t + 2) * kstep;
            const char* a3 = a2 + kstep; const char* b3 = b2 + kstep;
            PG8_LDB(B0, 0, 0); PG8_LDB(B1, 0, 1); PG8_SCHED; PG8_LDA(At, 0, 0); PG8_STAGE(PG8_SA(1, 1), a1 + hstepA, voffA);
            PG8_WAIT_V(8); PG8_WAIT_L(0); PG8_BAR; PG8_MMA(0, 0, At, B0); PG8_MMA(0, 1, At, B1); PG8_BAR; PG8_SCHED;
            PG8_LDA(At, 0, 1); PG8_STAGE(PG8_SB(0, 0), b2, voffB); PG8_STAGE(PG8_SB(0, 1), b2 + hstepB, voffB); PG8_STAGE(PG8_SA(0, 0), a2, voffA);
            PG8_WAIT_V(8); PG8_WAIT_L(0); PG8_BAR; PG8_MMA(1, 0, At, B0); PG8_MMA(1, 1, At, B1); PG8_BAR; PG8_SCHED;
            PG8_LDB(B0, 1, 0); PG8_LDB(B1, 1, 1); PG8_SCHED; PG8_LDA(At, 1, 0); PG8_STAGE(PG8_SA(0, 1), a2 + hstepA, voffA);
            PG8_WAIT_V(8); PG8_WAIT_L(0); PG8_BAR; PG8_MMA(0, 0, At, B0); PG8_MMA(0, 1, At, B1); PG8_BAR; PG8_SCHED;
            PG8_LDA(At, 1, 1); PG8_STAGE(PG8_SB(1, 0), b3, voffB); PG8_STAGE(PG8_SB(1, 1), b3 + hstepB, voffB); PG8_STAGE(PG8_SA(1, 0), a3, voffA);
            PG8_WAIT_V(8); PG8_WAIT_L(0); PG8_BAR; PG8_MMA(1, 0, At, B0); PG8_MMA(1, 1, At, B1); PG8_BAR; PG8_SCHED;
        }
        if constexpr (ALIGN_EPI) { if (wr == 0) PG8_BAR; }
        if constexpr (!Epi::AFTER_DRAIN) { E(acc, cur, wr, wc, fr, fq); }
        if (!has_next) break;
#pragma unroll
        for (int a = 0; a < 2; ++a)
#pragma unroll
            for (int b = 0; b < 2; ++b)
#pragma unroll
                for (int m = 0; m < 4; ++m)
#pragma unroll
                    for (int n = 0; n < 2; ++n) acc[a][b][m][n] = (f32x4){0.f, 0.f, 0.f, 0.f};
        cur = nxt; cA = nA; cB = nB; ++ui;
        if constexpr (ALIGN_EPI) { if (wr == 1) PG8_BAR; }
    }
    PG8_WAIT_V(0);
    if constexpr (!ALIGN_EPI) { if (wr == 0) PG8_BAR; }
    PG8_BAR;
    if constexpr (Epi::AFTER_DRAIN) { E.fused(acc, cur, wr, wc, fr, fq, lds, wid, lane); }
#undef PG8_SA
#undef PG8_SB
#undef PG8_STAGE
#undef PG8_LDA
#undef PG8_LDB
#undef PG8_MMA
#undef PG8_WAIT_V
#undef PG8_WAIT_L
#undef PG8_BAR
#undef PG8_SCHED
}
}

namespace pg8 {
__device__ __forceinline__ float rstd_of(const float* ss4, int row) { const f32x4 s = *(const f32x4*)(ss4 + (size_t)row * 4); return rsqrtf(((s[0] + s[1]) + (s[2] + s[3])) * (1.0f / D) + EPS); }

struct EpiIn {
    static constexpr bool AFTER_DRAIN = false;
    bf16_t* z; bf16_t* memkv; bf16_t* qmem; const float* ss4; const float* memss; float* vssp;
    __device__ __forceinline__ void operator()(const f32x4 (&acc)[2][2][4][2], const Unit& u, int wr, int wc, int fr, int fq) const {
        const bool main = (u.kind == 0), act = main && (u.pn < 6), vt = main && (u.pn >= 3) && (u.pn < 6);
        bf16_t* obase = main ? z : memkv; int ldc = main ? ZW : 1024;
        int col0 = u.pn * BM + wc * 32 + 8 * fq;
        if (main && u.pn == 6) { obase = qmem; ldc = MEMW; col0 -= 6 * BM; }
        const float* ssb = main ? ss4 : memss;
        float rsv[8];
#pragma unroll
        for (int j = 0; j < 8; ++j) rsv[j] = rstd_of(ssb, u.pm * BM + (j >> 2) * HALF + wr * 64 + (j & 3) * 16 + fr);
#pragma unroll
        for (int ai = 0; ai < 2; ++ai)
#pragma unroll
            for (int m = 0; m < 4; ++m) {
                const int row = u.pm * BM + ai * HALF + wr * 64 + m * 16 + fr;
                const float rs = rsv[ai * 4 + m];
                float sq = 0.f;
#pragma unroll
                for (int bj = 0; bj < 2; ++bj) {
                    f32x4 v0 = acc[ai][bj][m][0] * rs, v1 = acc[ai][bj][m][1] * rs;
                    if (act) {
#pragma unroll
                        for (int e = 0; e < 4; ++e) { v0[e] = gelu_tanh(v0[e]); v1[e] = gelu_tanh(v1[e]); }
                    }
                    sq += (v0[0] * v0[0] + v0[1] * v0[1]) + (v0[2] * v0[2] + v0[3] * v0[3]) + (v1[0] * v1[0] + v1[1] * v1[1]) + (v1[2] * v1[2] + v1[3] * v1[3]);
                    u32x4 w; w.x = pk2(v0[0], v0[1]); w.y = pk2(v0[2], v0[3]); w.z = pk2(v1[0], v1[1]); w.w = pk2(v1[2], v1[3]);
                    *(u32x4*)(obase + (size_t)row * ldc + col0 + bj * HALF) = w;
                }
                if (vt) { sq += __shfl_xor(sq, 16); sq += __shfl_xor(sq, 32); if (fq == 0) vssp[(size_t)row * 12 + (u.pn - 3) * 4 + wc] = sq; }
            }
    }
};

struct EpiKvq {
    static constexpr bool AFTER_DRAIN = false;
    bf16_t* kb; bf16_t* vb; bf16_t* qb; bf16_t* qmem; float* lf; const float* ss4; const float* b_f;
    __device__ __forceinline__ void operator()(const f32x4 (&acc)[2][2][4][2], const Unit& u, int wr, int wc, int fr, int fq) const {
        bf16_t* obase; int ldc, colt;
        if (u.pn < 3) { obase = kb; ldc = KVW; colt = u.pn * BM; } else if (u.pn < 6) { obase = vb; ldc = KVW; colt = (u.pn - 3) * BM; } else if (u.pn < 9) { obase = qb; ldc = KVW; colt = (u.pn - 6) * BM; } else { obase = qmem; ldc = MEMW; colt = 0; }
        const int col0 = colt + wc * 32 + 8 * fq;
        const bool ftile = (u.pn == 10);
        float rsv[8];
#pragma unroll
        for (int j = 0; j < 8; ++j) rsv[j] = rstd_of(ss4, u.pm * BM + (j >> 2) * HALF + wr * 64 + (j & 3) * 16 + fr);
#pragma unroll
        for (int ai = 0; ai < 2; ++ai)
#pragma unroll
            for (int m = 0; m < 4; ++m) {
                const int row = u.pm * BM + ai * HALF + wr * 64 + m * 16 + fr;
                const float rs = rsv[ai * 4 + m];
                if (!ftile) {
#pragma unroll
                    for (int bj = 0; bj < 2; ++bj) {
                        const f32x4 v0 = acc[ai][bj][m][0] * rs, v1 = acc[ai][bj][m][1] * rs;
                        u32x4 w; w.x = pk2(v0[0], v0[1]); w.y = pk2(v0[2], v0[3]); w.z = pk2(v1[0], v1[1]); w.w = pk2(v1[2], v1[3]);
                        *(u32x4*)(obase + (size_t)row * ldc + col0 + bj * HALF) = w;
                    }
                } else if (wc == 0 && fq < 2) {
                    const int b = row / SEQ, t = row % SEQ;
#pragma unroll
                    for (int n = 0; n < 2; ++n)
#pragma unroll
                        for (int e = 0; e < 4; ++e) { const int h = 8 * fq + 4 * n + e; if (h < NFOX) lf[((size_t)b * NFOX + h) * SEQ + t] = log_sigmoid_f(acc[ai][0][m][n][e] * rs + b_f[h]); }
                }
            }
    }
};

struct EpiRes {
    static constexpr bool AFTER_DRAIN = true;
    const float* R; float* xf; bf16_t* xb; float* ss4;
    __device__ __forceinline__ void fused(f32x4 (&acc)[2][2][4][2], const Unit& u, int wr, int wc, int fr, int fq, LAS unsigned char* lds, int wid, int lane) const {
        LAS float* P = (LAS float*)lds;
        const int col0 = u.pn * BM + wc * 32 + 8 * fq;
#pragma unroll
        for (int ai = 0; ai < 2; ++ai)
#pragma unroll
            for (int m = 0; m < 4; ++m) {
                const int rl = ai * HALF + wr * 64 + m * 16 + fr; const size_t off = (size_t)(u.pm * BM + rl) * D + col0;
                float sq = 0.f;
#pragma unroll
                for (int bj = 0; bj < 2; ++bj) {
                    const f32x4 r0 = *(const f32x4*)(R + off + bj * HALF), r1 = *(const f32x4*)(R + off + bj * HALF + 4);
                    const f32x4 v0 = acc[ai][bj][m][0] + r0, v1 = acc[ai][bj][m][1] + r1;
                    *(f32x4*)(xf + off + bj * HALF) = v0; *(f32x4*)(xf + off + bj * HALF + 4) = v1;
                    u32x4 w; w.x = pk2(v0[0], v0[1]); w.y = pk2(v0[2], v0[3]); w.z = pk2(v1[0], v1[1]); w.w = pk2(v1[2], v1[3]);
                    *(u32x4*)(xb + off + bj * HALF) = w;
                    sq += (v0[0] * v0[0] + v0[1] * v0[1]) + (v0[2] * v0[2] + v0[3] * v0[3]) + (v1[0] * v1[0] + v1[1] * v1[1]) + (v1[2] * v1[2] + v1[3] * v1[3]);
                }
                sq += __shfl_xor(sq, 16); sq += __shfl_xor(sq, 32);
                if (fq == 0) P[rl * 4 + wc] = sq;
            }
        __syncthreads();
        if (threadIdx.x < 256) { const int rl = threadIdx.x; const f32x4 p = *(const LAS f32x4*)(P + rl * 4); ss4[(size_t)(u.pm * BM + rl) * 4 + u.pn] = (p[0] + p[1]) + (p[2] + p[3]); }
        __syncthreads();
    }
};

__device__ __forceinline__ float dpp_shr1_f(float x) {
    int xi = __builtin_bit_cast(int, x);
    asm volatile("" : "+v"(xi));
    return __builtin_bit_cast(float, __builtin_amdgcn_update_dpp(0, xi, 0x111, 0xf, 0xf, true));
}
__device__ __forceinline__ f32x4 dpp_shr1(f32x4 v) { f32x4 r; r[0] = dpp_shr1_f(v[0]); r[1] = dpp_shr1_f(v[1]); r[2] = dpp_shr1_f(v[2]); r[3] = dpp_shr1_f(v[3]); return r; }
struct EpiFfn {
    static constexpr bool AFTER_DRAIN = false;
    bf16_t* g; float* halo; const float* ss4; const float* cw; const float* cb;
    __device__ __forceinline__ void operator()(f32x4 (&acc)[2][2][4][2], const Unit& u, int wr, int wc, int fr, int fq) const {
        const int T0 = u.pm * BM + wr * 128 + fr * 8;
        float rsv[8];
#pragma unroll
        for (int j = 0; j < 8; ++j) rsv[j] = rstd_of(ss4, T0 + j);
#pragma unroll
        for (int j = 0; j < 8; ++j) { const float r = rsv[j];
#pragma unroll
            for (int bj = 0; bj < 2; ++bj)
#pragma unroll
                for (int n = 0; n < 2; ++n) acc[j >> 2][bj][j & 3][n] *= r; }
        const int jc0 = u.pn * 128 + wc * 32 + 8 * fq;
        const int run = u.pm * 2 + wr;
        float* hrun = halo + (size_t)run * 4 * 5632 + u.pn * BM + wc * 32 + 8 * fq;
        unsigned pk[2][8][2];
#pragma unroll
        for (int n = 0; n < 2; ++n) {
            if (fr == 0) { *(f32x4*)(hrun + 4 * n) = acc[0][0][0][n]; *(f32x4*)(hrun + 5632 + 4 * n) = acc[0][0][1][n]; *(f32x4*)(hrun + HALF + 4 * n) = acc[0][1][0][n]; *(f32x4*)(hrun + 5632 + HALF + 4 * n) = acc[0][1][1][n]; }
            if (fr == 15) { *(f32x4*)(hrun + 2 * 5632 + 4 * n) = acc[1][0][2][n]; *(f32x4*)(hrun + 3 * 5632 + 4 * n) = acc[1][0][3][n]; *(f32x4*)(hrun + 2 * 5632 + HALF + 4 * n) = acc[1][1][2][n]; *(f32x4*)(hrun + 3 * 5632 + HALF + 4 * n) = acc[1][1][3][n]; }
        }
#pragma unroll
        for (int n = 0; n < 2; ++n) {
            const int cg = jc0 + 4 * n, cu = DFF + cg;
#pragma unroll
            for (int bj = 0; bj < 2; ++bj) {
                const int cc = bj ? cu : cg;
                const f32x4 w0 = *(const f32x4*)(cw + cc), w1 = *(const f32x4*)(cw + 5632 + cc), w2 = *(const f32x4*)(cw + 2 * 5632 + cc), bb = *(const f32x4*)(cb + cc);
                const f32x4 p1 = dpp_shr1(acc[1][bj][3][n]), p2 = dpp_shr1(acc[1][bj][2][n]);
#pragma unroll
                for (int j = 7; j >= 0; --j) {
                    const f32x4 h1 = j >= 1 ? acc[(j >= 1 ? j - 1 : 0) >> 2][bj][(j >= 1 ? j - 1 : 0) & 3][n] : p1;
                    const f32x4 h2 = j >= 2 ? acc[(j >= 2 ? j - 2 : 0) >> 2][bj][(j >= 2 ? j - 2 : 0) & 3][n] : (j == 1 ? p1 : p2);
                    acc[j >> 2][bj][j & 3][n] = bb + w2 * acc[j >> 2][bj][j & 3][n] + w1 * h1 + w0 * h2;
                }
            }
#pragma unroll
            for (int j = 0; j < 8; ++j) {
                const f32x4 cgv = acc[j >> 2][0][j & 3][n], cuv = acc[j >> 2][1][j & 3][n];
                f32x4 o;
#pragma unroll
                for (int e = 0; e < 4; ++e) o[e] = silu_f(cgv[e]) * cuv[e];
                pk[n][j][0] = pk2(o[0], o[1]); pk[n][j][1] = pk2(o[2], o[3]);
            }
        }
#pragma unroll
        for (int j = 0; j < 8; ++j) {
            u32x4 w; w.x = pk[0][j][0]; w.y = pk[0][j][1]; w.z = pk[1][j][0]; w.w = pk[1][j][1];
            *(u32x4*)(g + (size_t)(T0 + j) * DFF + jc0) = w;
        }
    }
};
}

__device__ __forceinline__ void fixup_phase(int vcu, int G, bf16_t* g, const float* halo, const float* cw, const float* cb) {
    for (int item = vcu; item < 256; item += G) {
        const int run = item >> 1, j = item & 1;
        if ((run & 15) == 0) continue;
        const float* hc = halo + (size_t)run * 4 * 5632; const float* hp = halo + (size_t)(run - 1) * 4 * 5632;
        for (int col = threadIdx.x; col < DFF; col += NTHR) {
            const int q = col >> 7, i = col & 127, ng = q * 256 + i, nu = ng + 128, cu = DFF + col;
            float r[2];
#pragma unroll
            for (int p = 0; p < 2; ++p) {
                const int nn = p ? nu : ng, cc = p ? cu : col;
                const float h0 = hc[nn], h1 = hc[5632 + nn], p2 = hp[2 * 5632 + nn], p3 = hp[3 * 5632 + nn];
                const float w0 = cw[cc], w1 = cw[5632 + cc], w2 = cw[2 * 5632 + cc], b = cb[cc];
                r[p] = (j == 0) ? (b + w2 * h0 + w1 * p3 + w0 * p2) : (b + w2 * h1 + w1 * h0 + w0 * p3);
            }
            g[(size_t)(run * 128 + j) * DFF + col] = (bf16_t)f2bf(silu_f(r[0]) * r[1]);
        }
    }
}

__device__ __forceinline__ void final_phase(int vcu, int G, int wave, int lane, float* xf, const float* ss4, const float* gain) {
    const int gw = vcu * NWAVES + wave, NGW = G * NWAVES;
    f32x4 gv[4];
#pragma unroll
    for (int j = 0; j < 4; ++j) gv[j] = *(const f32x4*)(gain + 4 * lane + 256 * j);
    for (int m = gw; m < M; m += NGW) {
        const float rs = pg8::rstd_of(ss4, m);
        f32x4* xr = (f32x4*)(xf + (size_t)m * D) + lane;
#pragma unroll
        for (int j = 0; j < 4; ++j) { const f32x4 v = xr[64 * j]; xr[64 * j] = v * rs * gv[j]; }
    }
}

struct TJob { const float* W; int ldw; int K; int ncols_valid; const float* gain; bf16_t* dst; };
__device__ __forceinline__ void transpose_item(const float* W, int ldw, int K, int k0, int srccol0, int ncols_valid, const float* gain, float scale, bf16_t* dst, int drow0, LAS float* scr, int lane) {
    const int n = lane & 31; const bool ok = (srccol0 + n) < ncols_valid;
#pragma unroll 8
    for (int i = 0; i < 32; ++i) { const int kk = 2 * i + (lane >> 5);
        float v = ok ? W[(size_t)(k0 + kk) * ldw + srccol0 + n] : 0.f;
        if (gain) v *= gain[k0 + kk];
        scr[kk * 33 + n] = v * scale; }
    asm volatile("s_waitcnt lgkmcnt(0)" ::: "memory");
    const int c = lane & 7;
#pragma unroll
    for (int j = 0; j < 4; ++j) { const int nn = (lane >> 3) + 8 * j; const LAS float* s = scr + (8 * c) * 33 + nn;
        u32x4 o; o.x = pk2(s[0 * 33], s[1 * 33]); o.y = pk2(s[2 * 33], s[3 * 33]); o.z = pk2(s[4 * 33], s[5 * 33]); o.w = pk2(s[6 * 33], s[7 * 33]);
        *(u32x4*)(dst + (size_t)(drow0 + nn) * K + k0 + 8 * c) = o; }
    asm volatile("s_waitcnt lgkmcnt(0)" ::: "memory");
}
__device__ __forceinline__ float row_to_bf16(const float* xrow, bf16_t* orow, int lane) {
    const f32x4* xr = (const f32x4*)xrow + lane;
    f32x4 v[4]; float s = 0.f;
#pragma unroll
    for (int j = 0; j < 4; ++j) { v[j] = xr[64 * j]; s += (v[j][0] * v[j][0] + v[j][1] * v[j][1]) + (v[j][2] * v[j][2] + v[j][3] * v[j][3]); }
    u32x2* o8 = (u32x2*)orow + lane;
#pragma unroll
    for (int j = 0; j < 4; ++j) { u32x2 w; w.x = pk2(v[j][0], v[j][1]); w.y = pk2(v[j][2], v[j][3]); o8[64 * j] = w; }
    return wave_sum(s);
}

namespace attn_body {
using bf16 = __hip_bfloat16;
constexpr int NW = 8, QBLK = 32, QB = QBLK * NW, KVBLK = 64;
__device__ __forceinline__ int crow(int r, int hi) { return (r & 3) + 8 * (r >> 2) + 4 * hi; }
#define SBAR() __builtin_amdgcn_sched_barrier(0)
__device__ __forceinline__ void cmask(f32x16& p0, f32x16& p1, int jb, int qrel, int hi) {
    const float NEG = -INFINITY; int kb = 64 * jb + 4 * hi;
#pragma unroll
    for (int r = 0; r < 16; ++r) { int kv = kb + (r & 3) + 8 * (r >> 2); if (kv > qrel) p0[r] = NEG; if (kv + 32 > qrel) p1[r] = NEG; }
}
constexpr int NSLOT = 3, SLOTB = 8192;
constexpr int LDS_K = 0, LDS_V = NSLOT * SLOTB, LDS_WS = 2 * NSLOT * SLOTB, LDS_OST = LDS_WS + NW * 64 * 4, LDS_ATT = LDS_OST + NW * 4096;
constexpr int LDS_BIAS = LDS_ATT, LDS_WTOT = LDS_BIAS + 8192, ATTN_LDS_BYTES = LDS_WTOT + 64;
__device__ __forceinline__ void glds16(const void* gsrc, unsigned lds_dst) { unsigned keep;
    asm volatile("s_mov_b32 %0, m0\n\ts_mov_b32 m0, %2\n\ts_nop 0\n\tglobal_load_lds_dwordx4 %1, off\n\ts_mov_b32 m0, %0" : "=&s"(keep) : "v"(gsrc), "s"(lds_dst) : "memory"); }
#define WAIT_BAR(N) asm volatile("s_waitcnt vmcnt(" #N ") lgkmcnt(0)\n\ts_barrier" ::: "memory")
typedef __attribute__((address_space(3))) const char* lds_cptr;
typedef short v4i16_t __attribute__((ext_vector_type(4)));
__device__ __forceinline__ void kload8(bf16x8* kf, lds_cptr kp) {
    kf[0] = *(const LAS bf16x8*)(kp);        kf[1] = *(const LAS bf16x8*)(kp + 512);
    kf[2] = *(const LAS bf16x8*)(kp + 2048); kf[3] = *(const LAS bf16x8*)(kp + 2560);
    kf[4] = *(const LAS bf16x8*)(kp + 4096); kf[5] = *(const LAS bf16x8*)(kp + 4608);
    kf[6] = *(const LAS bf16x8*)(kp + 6144); kf[7] = *(const LAS bf16x8*)(kp + 6656);
}
__device__ __forceinline__ void kload2(bf16x8* kf, lds_cptr kp, int j) { kf[2 * j] = *(const LAS bf16x8*)(kp + j * 2048); kf[2 * j + 1] = *(const LAS bf16x8*)(kp + j * 2048 + 512); }
__device__ __forceinline__ s16x4 vtr(lds_cptr p) { return __builtin_bit_cast(s16x4, __builtin_amdgcn_ds_read_tr16_b64_v4i16((LAS v4i16_t*)p)); }
#define MX3(a, b, c) __builtin_fmaxf(__builtin_fmaxf((a), (b)), (c))
__device__ __forceinline__ float rowmax(const f32x16& p0, const f32x16& p1) {
    float a = MX3(p0[0], p0[1], p1[0]), b = MX3(p0[2], p0[3], p1[1]); a = MX3(a, p1[2], p1[3]);
#pragma unroll
    for (int r = 4; r < 16; r += 4) { a = MX3(a, p0[r], p0[r + 1]); b = MX3(b, p0[r + 2], p0[r + 3]); a = MX3(a, p1[r], p1[r + 1]); b = MX3(b, p1[r + 2], p1[r + 3]); }
    float m = __builtin_fmaxf(a, b); auto rr = __builtin_amdgcn_permlane32_swap(__float_as_uint(m), __float_as_uint(m), false, false);
    return __builtin_fmaxf(__uint_as_float(rr[0]), __uint_as_float(rr[1]));
}
__device__ __forceinline__ void pv(f32x16* o, int vb, bf16x8 pa0, bf16x8 pa1, bf16x8 pa2, bf16x8 pa3) {
#pragma unroll
    for (int d0 = 0; d0 < 2; ++d0) { s16x4 lo[4], hi[4];
#pragma unroll
        for (int ks = 0; ks < 4; ++ks) {
            asm volatile("ds_read_b64_tr_b16 %0,%1 offset:%c2" : "=&v"(lo[ks]) : "v"(vb), "i"(d0 * 4096 + ks * 1024) : "memory");
            asm volatile("ds_read_b64_tr_b16 %0,%1 offset:%c2" : "=&v"(hi[ks]) : "v"(vb), "i"(d0 * 4096 + ks * 1024 + 512) : "memory"); }
        asm volatile("s_waitcnt lgkmcnt(0)" ::: "memory"); SBAR();
#define PK(k) (bf16x8){lo[k][0], lo[k][1], lo[k][2], lo[k][3], hi[k][0], hi[k][1], hi[k][2], hi[k][3]}
        o[d0] = __builtin_amdgcn_mfma_f32_32x32x16_bf16(pa0, PK(0), o[d0], 0, 0, 0);
        o[d0] = __builtin_amdgcn_mfma_f32_32x32x16_bf16(pa1, PK(1), o[d0], 0, 0, 0);
        o[d0] = __builtin_amdgcn_mfma_f32_32x32x16_bf16(pa2, PK(2), o[d0], 0, 0, 0);
        o[d0] = __builtin_amdgcn_mfma_f32_32x32x16_bf16(pa3, PK(3), o[d0], 0, 0, 0);
#undef PK
    }
}

template <bool FOX, int THRL, int qp, int kp, int vp, int op>
__device__ __forceinline__ void attn_unit(const bf16* Q, const bf16* __restrict__ K, const bf16* __restrict__ V, bf16* O, int NT, char* shm) {
    int tid = threadIdx.x; asm volatile("" : "+v"(tid));
    const int lane = tid & 63, r32 = lane & 31, hi = lane >> 5; const int wid = __builtin_amdgcn_readfirstlane(tid >> 6);
    const bf16* Qw = Q + (long)(wid * QBLK) * qp;
    const unsigned lds0 = (unsigned)(uintptr_t)shm;
    float* wsf = (float*)(shm + LDS_WS) + wid * 64;
    const bf16* ksrc = K + (long)lane * kp + wid * 8;
    const bf16* vsrc = V + (long)(16 * (wid & 3) + (lane >> 2)) * vp + (wid >> 2) * 32 + (lane & 3) * 8;
    const unsigned kdst = lds0 + LDS_K + wid * 1024, vdst = lds0 + LDS_V + wid * 1024;
#define DMA_K(t, slot) glds16(ksrc + (long)(t) * KVBLK * kp, (unsigned)__builtin_amdgcn_readfirstlane(kdst + (slot)))
#define DMA_V(t, slot) glds16(vsrc + (long)(t) * KVBLK * vp, (unsigned)__builtin_amdgcn_readfirstlane(vdst + (slot)))
    const int vb0 = (int)(lds0 + LDS_V) + ((lane >> 4) & 1) * 32 + (lane & 3) * 8 + (4 * hi + ((lane & 15) >> 2)) * 64;
    const char* Kbase = shm + LDS_K; bf16x8 kf[8];
    const lds_cptr shm3 = (lds_cptr)shm; const lds_cptr kp0 = shm3 + LDS_K + hi * 1024 + r32 * 16; const lds_cptr vp0 = shm3 + LDS_V + ((lane >> 4) & 1) * 32 + (lane & 3) * 8 + (4 * hi + ((lane & 15) >> 2)) * 64;
    const LAS float* biasL = (const LAS float*)(shm3 + LDS_BIAS) + 4 * hi;
    DMA_K(0, 0); DMA_V(0, 0); DMA_K(1, SLOTB);
    bf16x8 qr[4];
#pragma unroll
    for (int d0 = 0; d0 < 4; ++d0) qr[d0] = *reinterpret_cast<const bf16x8*>(&Qw[(long)r32 * qp + d0 * 16 + hi * 8]);
    const int qrel = wid * QBLK + r32;
    float mhat = 0.f, l_reg = 0.f; f32x16 o[2]; o[0] = f32x16{}; o[1] = f32x16{};
    float sq = 0.f;
    if (FOX) sq = -((const LAS float*)(shm3 + LDS_BIAS))[(NT - 4) * KVBLK + qrel];
    bool resc = false;
#define CINIT(C0, C1, t) do { if (FOX) { const LAS float* bp_ = biasL + (t) * KVBLK; \
        _Pragma("unroll") for (int a_ = 0; a_ < 4; ++a_) { const f32x4 b0_ = *(const LAS f32x4*)(bp_ + 8 * a_), b1_ = *(const LAS f32x4*)(bp_ + 32 + 8 * a_); \
            _Pragma("unroll") for (int e_ = 0; e_ < 4; ++e_) { C0[4 * a_ + e_] = b0_[e_] + sq; C1[4 * a_ + e_] = b1_[e_] + sq; } } } \
      else { _Pragma("unroll") for (int r_ = 0; r_ < 16; ++r_) { C0[r_] = sq; C1[r_] = sq; } } } while (0)
#define DECIDE(C0, C1) do { float rm = rowmax(C0, C1); resc = false; \
      if (__builtin_expect(__any(rm > (float)THRL), 0)) { const float dl = __builtin_fmaxf(rm, 0.f); mhat += dl; sq -= dl; \
        _Pragma("unroll") for (int r = 0; r < 16; ++r) { C0[r] -= dl; C1[r] -= dl; } \
        const float f = __builtin_amdgcn_exp2f(-dl); l_reg *= f; if (hi == 0) wsf[r32] = f; resc = true; } } while (0)
#define RESC() do { if (resc) { asm volatile("s_waitcnt lgkmcnt(0)" ::: "memory"); \
      _Pragma("unroll") for (int d_ = 0; d_ < 2; ++d_) _Pragma("unroll") for (int r = 0; r < 16; ++r) o[d_][r] *= wsf[crow(r, hi)]; } } while (0)
#define CMASK(P0, P1, t) do { if (FOX) { int jb_ = (t) - (NT - 4); if (jb_ >= 0) cmask(P0, P1, jb_, qrel, hi); } } while (0)
    f32x16 pA0, pA1, pB0, pB1;
    int sl_prev = 0, sl_cur = 0, sl_next = SLOTB;
#define ROT() do { sl_prev = sl_cur; sl_cur = sl_next; sl_next = (sl_next == (NSLOT - 1) * SLOTB) ? 0 : sl_next + SLOTB; } while (0)
    DMA_K(2, 2 * SLOTB);
    WAIT_BAR(3);
    CINIT(pA0, pA1, 0);
    {
        const char* kb = Kbase + hi * 1024 + r32 * 16;
#pragma unroll
        for (int d0 = 0; d0 < 4; ++d0) {
            const bf16x8 b0 = *reinterpret_cast<const bf16x8*>(kb + d0 * 2048);
            const bf16x8 b1 = *reinterpret_cast<const bf16x8*>(kb + d0 * 2048 + 512);
            pA0 = __builtin_amdgcn_mfma_f32_32x32x16_bf16(b0, qr[d0], pA0, 0, 0, 0); pA1 = __builtin_amdgcn_mfma_f32_32x32x16_bf16(b1, qr[d0], pA1, 0, 0, 0); }
    }
    CMASK(pA0, pA1, 0);
    DECIDE(pA0, pA1);
#pragma unroll
    for (int r = 0; r < 16; ++r) { pA0[r] = __builtin_amdgcn_exp2f(pA0[r]); pA1[r] = __builtin_amdgcn_exp2f(pA1[r]); }
    WAIT_BAR(0);
    DMA_K(3, 0); DMA_V(1, SLOTB);
    ROT();
    kload8(kf, kp0 + sl_cur);
    WAIT_BAR(2);
    s16x4 vlo[8], vhi[8]; u32x4 pw0, pw1, pw2, pw3;
#define PKW(P, B) pk2(P[B], P[B + 1])
#define PAF(k) __builtin_bit_cast(bf16x8, pw##k)
#define VFR(i) (bf16x8){vlo[i][0], vlo[i][1], vlo[i][2], vlo[i][3], vhi[i][0], vhi[i][1], vhi[i][2], vhi[i][3]}
#define PIN(x) asm volatile("" : "+v"(x))
#define GAPA(MF, A0, A1, A2, A3, W0, W1, PW) do { MF; sacc += A0; sacc += A1; sacc += A2; sacc += A3; PIN(sacc); W0; W1; PIN(PW); SBAR(); } while (0)
#define EX(v) __builtin_amdgcn_exp2f(v)
#define GAPB(MF, X, B) do { MF; X[B] = EX(X[B]); X[B + 1] = EX(X[B + 1]); X[B + 2] = EX(X[B + 2]); X[B + 3] = EX(X[B + 3]); PIN(X); SBAR(); } while (0)
#define VRD(i) do { vlo[i] = vtr(vp_ + (((i) >> 2) * 4096 + ((i) & 3) * 1024)); vhi[i] = vtr(vp_ + (((i) >> 2) * 4096 + ((i) & 3) * 1024 + 512)); } while (0)
#define KRD(G, j) do { if (G) { kload2(kf, kp0 + sl_next, j); SBAR(); } } while (0)
#define STEP(C0, C1, P0, P1, t, GK, GV, GL) do { SBAR(); \
    const lds_cptr vp_ = vp0 + sl_prev; \
    CINIT(C0, C1, t); SBAR(); \
    VRD(0); SBAR(); float sacc = (P0[0] + P0[1]); \
    GAPA(C0 = __builtin_amdgcn_mfma_f32_32x32x16_bf16(kf[0], qr[0], C0, 0, 0, 0), P0[2], P0[3], P0[4], P0[5],     pw0[0] = PKW(P0, 0), pw0[1] = PKW(P0, 2), pw0); \
    VRD(4); SBAR(); GAPA(C1 = __builtin_amdgcn_mfma_f32_32x32x16_bf16(kf[1], qr[0], C1, 0, 0, 0), P0[6], P0[7], P0[8], P0[9],     pw0[2] = PKW(P0, 4), pw0[3] = PKW(P0, 6), pw0); \
    VRD(1); SBAR(); GAPA(C0 = __builtin_amdgcn_mfma_f32_32x32x16_bf16(kf[2], qr[1], C0, 0, 0, 0),   P0[10], P0[11], P0[12], P0[13], pw1[0] = PKW(P0, 8), pw1[1] = PKW(P0, 10), pw1); \
    VRD(5); SBAR(); GAPA(C1 = __builtin_amdgcn_mfma_f32_32x32x16_bf16(kf[3], qr[1], C1, 0, 0, 0),   P0[14], P0[15], P1[0], P1[1],   pw1[2] = PKW(P0, 12), pw1[3] = PKW(P0, 14), pw1); \
    VRD(2); SBAR(); GAPA(C0 = __builtin_amdgcn_mfma_f32_32x32x16_bf16(kf[4], qr[2], C0, 0, 0, 0),   P1[2], P1[3], P1[4], P1[5],     pw2[0] = PKW(P1, 0), pw2[1] = PKW(P1, 2), pw2); \
    VRD(6); SBAR(); GAPA(C1 = __builtin_amdgcn_mfma_f32_32x32x16_bf16(kf[5], qr[2], C1, 0, 0, 0),   P1[6], P1[7], P1[8], P1[9],     pw2[2] = PKW(P1, 4), pw2[3] = PKW(P1, 6), pw2); \
    VRD(3); SBAR(); GAPA(C0 = __builtin_amdgcn_mfma_f32_32x32x16_bf16(kf[6], qr[3], C0, 0, 0, 0),   P1[10], P1[11], P1[12], P1[13], pw3[0] = PKW(P1, 8), pw3[1] = PKW(P1, 10), pw3); \
    VRD(7); SBAR(); GAPA(C1 = __builtin_amdgcn_mfma_f32_32x32x16_bf16(kf[7], qr[3], C1, 0, 0, 0),   P1[14], P1[15], 0.f, 0.f,       pw3[2] = PKW(P1, 12), pw3[3] = PKW(P1, 14), pw3); \
    l_reg += sacc; \
    if (GK) { DMA_K((t) + 3, sl_cur); } if (GV) { DMA_V((t) + 1, sl_next); } \
    CMASK(C0, C1, t); \
    DECIDE(C0, C1); \
    SBAR(); \
    GAPB(o[0] = __builtin_amdgcn_mfma_f32_32x32x16_bf16(PAF(0), VFR(0), o[0], 0, 0, 0), C0, 0); \
    GAPB(o[1] = __builtin_amdgcn_mfma_f32_32x32x16_bf16(PAF(0), VFR(4), o[1], 0, 0, 0), C0, 4); \
    KRD(GL, 0); GAPB(o[0] = __builtin_amdgcn_mfma_f32_32x32x16_bf16(PAF(1), VFR(1), o[0], 0, 0, 0), C0, 8); \
    KRD(GL, 1); GAPB(o[1] = __builtin_amdgcn_mfma_f32_32x32x16_bf16(PAF(1), VFR(5), o[1], 0, 0, 0), C0, 12); \
    KRD(GL, 2); GAPB(o[0] = __builtin_amdgcn_mfma_f32_32x32x16_bf16(PAF(2), VFR(2), o[0], 0, 0, 0), C1, 0); \
    KRD(GL, 3); GAPB(o[1] = __builtin_amdgcn_mfma_f32_32x32x16_bf16(PAF(2), VFR(6), o[1], 0, 0, 0), C1, 4); \
    GAPB(o[0] = __builtin_amdgcn_mfma_f32_32x32x16_bf16(PAF(3), VFR(3), o[0], 0, 0, 0), C1, 8); \
    GAPB(o[1] = __builtin_amdgcn_mfma_f32_32x32x16_bf16(PAF(3), VFR(7), o[1], 0, 0, 0), C1, 12); \
    } while (0)
    int t = 1;
    for (; t + 5 < NT; t += 2) {
        STEP(pB0, pB1, pA0, pA1, t, true, true, true);     WAIT_BAR(2); RESC(); ROT();
        STEP(pA0, pA1, pB0, pB1, t + 1, true, true, true); WAIT_BAR(2); RESC(); ROT();
    }
#define ENDW(tt) do { if ((tt) + 3 < NT) { WAIT_BAR(2); } else if ((tt) + 2 < NT) { WAIT_BAR(1); } else { WAIT_BAR(0); } } while (0)
    for (; t + 1 < NT; t += 2) {
        STEP(pB0, pB1, pA0, pA1, t, (t + 3 < NT), (t + 1 < NT), (t + 1 < NT));       ENDW(t);     RESC(); ROT();
        STEP(pA0, pA1, pB0, pB1, t + 1, (t + 4 < NT), (t + 2 < NT), (t + 2 < NT));   ENDW(t + 1); RESC(); ROT();
    }
    STEP(pB0, pB1, pA0, pA1, NT - 1, false, false, false); RESC();
    { float sacc = pB0[0] + pB0[1];
#pragma unroll
      for (int r = 2; r < 16; ++r) sacc += pB0[r];
#pragma unroll
      for (int r = 0; r < 16; ++r) sacc += pB1[r];
      l_reg += sacc;
      pw0 = (u32x4){PKW(pB0, 0), PKW(pB0, 2), PKW(pB0, 4), PKW(pB0, 6)}; pw1 = (u32x4){PKW(pB0, 8), PKW(pB0, 10), PKW(pB0, 12), PKW(pB0, 14)};
      pw2 = (u32x4){PKW(pB1, 0), PKW(pB1, 2), PKW(pB1, 4), PKW(pB1, 6)}; pw3 = (u32x4){PKW(pB1, 8), PKW(pB1, 10), PKW(pB1, 12), PKW(pB1, 14)};
      SBAR(); pv(o, vb0 + sl_cur, PAF(0), PAF(1), PAF(2), PAF(3)); }
    { auto rr = __builtin_amdgcn_permlane32_swap(__float_as_uint(l_reg), __float_as_uint(l_reg), false, false); l_reg = __uint_as_float(rr[0]) + __uint_as_float(rr[1]); }
    if (hi == 0) wsf[32 + r32] = l_reg; asm volatile("s_waitcnt lgkmcnt(0)" ::: "memory");
    float rli[16];
#pragma unroll
    for (int r = 0; r < 16; ++r) rli[r] = __builtin_amdgcn_rcpf(wsf[32 + crow(r, hi)]);
    bf16* Ow = O + (long)(wid * QBLK) * op;
    { bf16* stg = (bf16*)(shm + LDS_OST) + wid * 2048;
#pragma unroll
      for (int r = 0; r < 16; ++r) { const int orow = crow(r, hi);
#pragma unroll
          for (int d0 = 0; d0 < 2; ++d0) stg[orow * 64 + d0 * 32 + r32] = __float2bfloat16(o[d0][r] * rli[r]); }
      asm volatile("s_waitcnt lgkmcnt(0)" ::: "memory");
#pragma unroll
      for (int i = 0; i < 4; ++i) { const int row = i * 8 + (lane >> 3), ch = lane & 7; const u32x4 v = *(const u32x4*)(stg + row * 64 + ch * 8); *(u32x4*)(Ow + (long)row * op + ch * 8) = v; } }
    asm volatile("s_waitcnt lgkmcnt(0)\n\ts_barrier" ::: "memory");
#undef DMA_K
#undef DMA_V
#undef CINIT
#undef DECIDE
#undef RESC
#undef CMASK
#undef ROT
#undef PKW
#undef PAF
#undef VFR
#undef PIN
#undef GAPA
#undef GAPB
#undef EX
#undef VRD
#undef KRD
#undef STEP
#undef ENDW
}

__device__ __forceinline__ void bias_scan(const float* lf, int n, char* shm) {
    int tid = threadIdx.x; asm volatile("" : "+v"(tid));
    const int lane = tid & 63, wid = tid >> 6;
    LAS float* bias = (LAS float*)((lds_cptr)shm + LDS_BIAS); LAS float* wtot = (LAS float*)((lds_cptr)shm + LDS_WTOT);
    f32x4 v = (f32x4){0.f, 0.f, 0.f, 0.f};
    if (4 * tid < n) v = *(const f32x4*)(lf + 4 * tid);
    v[1] += v[0]; v[2] += v[1]; v[3] += v[2];
    float s = v[3];
#pragma unroll
    for (int o = 1; o < 64; o <<= 1) { const float u = __shfl_up(s, o); if (lane >= o) s += u; }
    if (lane == 63) wtot[wid] = s;
    __syncthreads();
    float base = s - v[3];
    for (int w = 0; w < wid; ++w) base += wtot[w];
    if (4 * tid < n) { f32x4 r; r[0] = -(base + v[0]) * LOG2E; r[1] = -(base + v[1]) * LOG2E; r[2] = -(base + v[2]) * LOG2E; r[3] = -(base + v[3]) * LOG2E; *(LAS f32x4*)(bias + 4 * tid) = r; }
    __syncthreads();
}
#undef SBAR
#undef WAIT_BAR
#undef MX3
}

constexpr int GM_VSTRIDE = 416;
constexpr int GM_RSTD_OFF = 128 * GM_VSTRIDE;
__device__ __forceinline__ void gmlp_unit(int b, int n, int g, const bf16_t* z, const float* vssp, const float* w_s, const float* b_s, const float* vgain, bf16_t* mix, char* shm) {
    typedef __attribute__((address_space(3))) char* lds_ptr;
    int tid = threadIdx.x; asm volatile("" : "+v"(tid));
    const int lane = tid & 63, fr = lane & 15, fq = lane >> 4; const int wid = __builtin_amdgcn_readfirstlane(tid >> 6);
    const int t0 = b * SEQ + n * 128;
    lds_ptr sh = (lds_ptr)shm; LAS float* rstd = (LAS float*)(sh + GM_RSTD_OFF);
#pragma unroll
    for (int i = 0; i < 6; ++i) { const int idx = tid + NTHR * i, row = idx / 24, ch = idx % 24;
        const u32x4 w = *(const u32x4*)(z + (size_t)(t0 + row) * ZW + TOK + 192 * g + ch * 8);
        const int p = ch >> 2, a = ch & 3; lds_ptr dst = sh + row * GM_VSTRIDE + p * 64 + a * 8;
        *(LAS u32x2*)(dst) = (u32x2){w.x, w.y}; *(LAS u32x2*)(dst + 32) = (u32x2){w.z, w.w}; }
    if (tid < 128) { const float* p = vssp + (size_t)(t0 + tid) * 12; float s = 0.f;
#pragma unroll
        for (int i = 0; i < 12; ++i) s += p[i];
        rstd[tid] = rsqrtf(s * (1.0f / TOK) + EPS); }
    __syncthreads();
    f32x4 acc[12];
#pragma unroll
    for (int i = 0; i < 12; ++i) acc[i] = (f32x4){0.f, 0.f, 0.f, 0.f};
    const int trow = 16 * wid + fr;
    const int nks = (wid >> 1) + 1;
    const float* wrow = w_s + ((size_t)g * 128 + trow) * 128;
    for (int ks = 0; ks < nks; ++ks) {
        const int s0 = 32 * ks + 4 * fq;
        const f32x4 w0 = *(const f32x4*)(wrow + s0), w1 = *(const f32x4*)(wrow + s0 + 16);
        const f32x4 r0 = *(const LAS f32x4*)(rstd + s0), r1 = *(const LAS f32x4*)(rstd + s0 + 16);
        float wv[8];
#pragma unroll
        for (int e = 0; e < 4; ++e) { wv[e] = (s0 + e <= trow) ? w0[e] * r0[e] : 0.f; wv[4 + e] = (s0 + 16 + e <= trow) ? w1[e] * r1[e] : 0.f; }
        u32x4 wp; wp.x = pk2(wv[0], wv[1]); wp.y = pk2(wv[2], wv[3]); wp.z = pk2(wv[4], wv[5]); wp.w = pk2(wv[6], wv[7]);
        const bf16x8 wfrag = __builtin_bit_cast(bf16x8, wp);
        lds_ptr vbase = sh + (32 * ks + 4 * fq + (fr >> 2)) * GM_VSTRIDE + (fr & 3) * 8;
#pragma unroll
        for (int nb = 0; nb < 12; ++nb) {
            const s16x4 lo = __builtin_bit_cast(s16x4, __builtin_amdgcn_ds_read_tr16_b64_v4i16((LAS attn_body::v4i16_t*)(vbase + (nb >> 1) * 64 + (nb & 1) * 32)));
            const s16x4 hi = __builtin_bit_cast(s16x4, __builtin_amdgcn_ds_read_tr16_b64_v4i16((LAS attn_body::v4i16_t*)(vbase + 16 * GM_VSTRIDE + (nb >> 1) * 64 + (nb & 1) * 32)));
            const bf16x8 vfrag = (bf16x8){lo[0], lo[1], lo[2], lo[3], hi[0], hi[1], hi[2], hi[3]};
            acc[nb] = __builtin_amdgcn_mfma_f32_16x16x32_bf16(vfrag, wfrag, acc[nb], 0, 0, 0);
        }
    }
    const float bs = b_s[g * 128 + trow];
    const size_t rowoff = (size_t)(t0 + trow);
#pragma unroll
    for (int p = 0; p < 6; ++p) {
        const int c0 = 192 * g + 32 * p + 8 * fq;
        const f32x4 g0 = *(const f32x4*)(vgain + c0), g1 = *(const f32x4*)(vgain + c0 + 4);
        const u32x4 uu = *(const u32x4*)(z + rowoff * ZW + c0);
        f32x4 m0 = acc[2 * p] * g0 + bs, m1 = acc[2 * p + 1] * g1 + bs;
        u32x4 w; w.x = pk2(bf_lo(uu.x) * m0[0], bf_hi(uu.x) * m0[1]); w.y = pk2(bf_lo(uu.y) * m0[2], bf_hi(uu.y) * m0[3]);
        w.z = pk2(bf_lo(uu.z) * m1[0], bf_hi(uu.z) * m1[1]); w.w = pk2(bf_lo(uu.w) * m1[2], bf_hi(uu.w) * m1[3]);
        *(u32x4*)(mix + rowoff * D + c0) = w;
    }
    __syncthreads();
}

constexpr int N_PHASES = 14;
#ifndef MK_DBG_PTR
#define MK_DBG_PTR nullptr
#endif
struct Args { const float* in[29]; float* out; unsigned char* ws; int ph_lo, ph_hi; };

__global__ void __launch_bounds__(NTHR, 2) mk_fwd(Args args) {
    extern __shared__ __attribute__((aligned(16))) unsigned char lds[];
    LAS unsigned char* L = (LAS unsigned char*)lds;
    volatile LAS unsigned* MISC = (volatile LAS unsigned*)(L + MISC_OFF);
    const int tid = threadIdx.x, lane = tid & 63, wave = __builtin_amdgcn_readfirstlane(tid >> 6);
    const int G = gridDim.x; const int bx = blockIdx.x; const int vcu = (G % 8 == 0) ? (bx % 8) * (G / 8) + bx / 8 : bx;
    unsigned char* ws = args.ws;
#define in args.in
#define xf args.out
#define P_BF(off) ((bf16_t*)(ws + (off)))
#define P_F32(off) ((float*)(ws + (off)))
#define Win P_BF(WS_WIN)
#define Wmem P_BF(WS_WMEM)
#define AWout P_BF(WS_AWOUT)
#define Affi P_BF(WS_AFFI)
#define Affo P_BF(WS_AFFO)
#define Kvq P_BF(WS_KVQ)
#define BWout P_BF(WS_BWOUT)
#define Bffi P_BF(WS_BFFI)
#define Bffo P_BF(WS_BFFO)
#define xb P_BF(WS_XB)
#define mix P_BF(WS_MIX)
#define memb P_BF(WS_MEMB)
#define memkv P_BF(WS_MEMKV)
#define qmem P_BF(WS_QMEM)
#define ss4 P_F32(WS_SS4)
#define memss P_F32(WS_MEMSS)
#define vssp P_F32(WS_VSSP)
#define lf P_F32(WS_LF)
#define halo P_F32(WS_HALO)
#define zb P_BF(WS_R1)
#define gb P_BF(WS_R1)
#define kb P_BF(WS_KB)
#define vb P_BF(WS_VB)
#define qb P_BF(WS_QB)
    if (tid < 64) ((LAS unsigned*)(L + MISC_OFF))[tid] = 0u;
    __syncthreads();
    const int lo = args.ph_lo, hi = args.ph_hi;
    const bool use_bar = (hi - lo) > 1;
    XcdBarrier bar; bar.bar = (unsigned*)(ws + WS_CTL) + 4096; bar.x = 0; bar.st = nullptr;
    if (use_bar) bar = xcd_barrier_post((unsigned*)(ws + WS_CTL) + 4096, MISC + 8);
#define IN(k) (lo <= (k) && (k) < hi)
#define SEAM(k) do { if (IN(k) && IN((k) + 1)) xcd_barrier(bar); } while (0)

    if (IN(0)) {
        LAS float* scr = (LAS float*)(L + wave * 16384);
        const int gw = vcu * NWAVES + wave, NGW = G * NWAVES;
        constexpr int I0 = 16 * 56, I1 = 16 * 32, I2 = 16 * 32, I3 = 16 * 176, I4 = 44 * 32, I5 = 16 * 88, I6 = 16 * 32, I7 = 16 * 176, I8 = 44 * 32;
        constexpr int NITEMS = I0 + I1 + I2 + I3 + I4 + I5 + I6 + I7 + I8;
        for (int it = gw; it < NITEMS; it += NGW) {
            int r = it;
            if (r < I0) { const int nb = r % 56, kb_ = r / 56; transpose_item(in[3], ZW, D, 64 * kb_, 32 * nb, ZW, in[2], (32 * nb >= 1536) ? C2 : 1.f, Win, 32 * nb, scr, lane); continue; } r -= I0;
            if (r < I1) { const int nb = r % 32, kb_ = r / 32; const bool lb = nb >= 16;
                transpose_item(lb ? in[21] : in[8], 512, D, 64 * kb_, 32 * (nb & 15), 512, lb ? in[20] : in[7], 1.f, Wmem, 32 * nb, scr, lane); continue; } r -= I1;
            if (r < I2) { const int nb = r % 32, kb_ = r / 32; transpose_item(in[9], D, D, 64 * kb_, 32 * nb, D, nullptr, 1.f, AWout, 32 * nb, scr, lane); continue; } r -= I2;
            if (r < I3 || (r >= I3 + I4 + I5 + I6 && r < I3 + I4 + I5 + I6 + I7)) { const bool lb = r >= I3; if (lb) r -= I3 + I4 + I5 + I6;
                const int nb = r % 176, kb_ = r / 176; const int n0 = 32 * nb, q = n0 >> 8, i = n0 & 255; const int src = (i < 128) ? (128 * q + i) : (DFF + 128 * q + (i - 128));
                transpose_item(lb ? in[24] : in[11], 5632, D, 64 * kb_, src, 5632, lb ? in[23] : in[10], 1.f, lb ? Bffi : Affi, n0, scr, lane); continue; } r -= I3;
            if (r < I4) { const int nb = r % 32, kb_ = r / 32; transpose_item(in[14], D, DFF, 64 * kb_, 32 * nb, D, nullptr, 1.f, Affo, 32 * nb, scr, lane); continue; } r -= I4;
            if (r < I5) { const int nb = r % 88, kb_ = r / 88; const int n0 = 32 * nb;
                if (n0 < 1536) transpose_item(in[16], 1548, D, 64 * kb_, n0, 1548, in[15], 1.f, Kvq, n0, scr, lane);
                else if (n0 < 2560) transpose_item(in[19], D, D, 64 * kb_, n0 - 1536, D, in[18], C2, Kvq, n0, scr, lane);
                else transpose_item(in[16], 1548, D, 64 * kb_, 1536 + (n0 - 2560), (n0 == 2560) ? 1548 : 0, in[15], 1.f, Kvq, n0, scr, lane);
                continue; } r -= I5;
            if (r < I6) { const int nb = r % 32, kb_ = r / 32; transpose_item(in[22], D, D, 64 * kb_, 32 * nb, D, nullptr, 1.f, BWout, 32 * nb, scr, lane); continue; } r -= I6;
            r -= I7;
            { const int nb = r % 32, kb_ = r / 32; transpose_item(in[27], D, DFF, 64 * kb_, 32 * nb, D, nullptr, 1.f, Bffo, 32 * nb, scr, lane); }
        }
        for (int m = gw; m < M; m += NGW) { const float s = row_to_bf16(in[0] + (size_t)m * D, xb + (size_t)m * D, lane); if (lane == 0) *(f32x4*)(ss4 + (size_t)m * 4) = (f32x4){s, 0.f, 0.f, 0.f}; }
        for (int m = gw; m < MROWS; m += NGW) { const float s = row_to_bf16(in[1] + (size_t)m * D, memb + (size_t)m * D, lane); if (lane == 0) *(f32x4*)(memss + (size_t)m * 4) = (f32x4){s, 0.f, 0.f, 0.f}; }
    }
    SEAM(0);
    if (IN(1)) {
        pg8::Sched S; S.init(M, ZW, D, G, bx, xb, Win); S.extra(MROWS, 1024, memb, Wmem);
        pg8::EpiIn E{zb, memkv, qmem, ss4, memss, vssp};
        pg8::gemm_phase<pg8::EpiIn, true, false>(L, S, E);
    }
    SEAM(1);
    if (IN(2)) {
        for (int uidx = vcu; uidx < 512; uidx += G) gmlp_unit(uidx >> 6, (uidx >> 2) & 15, uidx & 3, zb, vssp, in[5], in[6], in[4], mix, (char*)lds);
        for (int uidx = vcu; uidx < 256; uidx += G) { const int b = uidx >> 5, h = (uidx >> 3) & 3, qt = uidx & 7;
            const size_t row0 = (size_t)b * SEQ + qt * 256;
            attn_body::attn_unit<false, 8, MEMW, 1024, 1024, D>((const attn_body::bf16*)qmem + row0 * MEMW + 64 * h, (const attn_body::bf16*)memkv + (size_t)b * NMEM * 1024 + 64 * h,
                                           (const attn_body::bf16*)memkv + (size_t)b * NMEM * 1024 + 256 + 64 * h, (attn_body::bf16*)mix + row0 * D + TOK + 64 * h, 4, (char*)lds); }
    }
    SEAM(2);
    if (IN(3)) {
        pg8::Sched S; S.init(M, D, D, G, bx, mix, AWout);
        pg8::EpiRes E{in[0], xf, xb, ss4};
        pg8::gemm_phase<pg8::EpiRes, false, false>(L, S, E);
    }
    SEAM(3);
    if (IN(4)) {
        pg8::Sched S; S.init(M, 2 * DFF, D, G, bx, xb, Affi);
        pg8::EpiFfn E{gb, halo, ss4, in[12], in[13]};
        pg8::gemm_phase<pg8::EpiFfn, true, true>(L, S, E);
    }
    SEAM(4);
    if (IN(5)) fixup_phase(vcu, G, gb, halo, in[12], in[13]);
    SEAM(5);
    if (IN(6)) {
        pg8::Sched S; S.init(M, D, DFF, G, bx, gb, Affo);
        pg8::EpiRes E{xf, xf, xb, ss4};
        pg8::gemm_phase<pg8::EpiRes, false, false>(L, S, E);
    }
    SEAM(6);
    if (IN(7)) {
        pg8::Sched S; S.init(M, 2816, D, G, bx, xb, Kvq);
        pg8::EpiKvq E{kb, vb, qb, qmem, lf, ss4, in[17]};
        pg8::gemm_phase<pg8::EpiKvq, true, false>(L, S, E);
    }
    SEAM(7);
    if (IN(8)) {
        for (int v = vcu; v < 256; v += G) {
            const int grp = v >> 3, k8 = v & 7;
            const unsigned tbe = k8 == 0 ? 0x000c1cu : k8 == 1 ? 0x040d1du : k8 == 2 ? 0x05081eu : k8 == 3 ? 0x011018u : k8 == 4 ? 0x021419u : k8 == 5 ? 0x06111au : k8 == 6 ? 0x091215u : 0x0a0e16u;
#pragma unroll 1
            for (int i = 0; i < 3; ++i) {
                const unsigned e = (tbe >> (8 * i)) & 0xffu; const int qb_ = (int)(e >> 2), cp = (int)(e & 3u);
                const int bh = grp * 3 + cp, b = bh / NFOX, h = bh % NFOX;
                const int NT = 4 * qb_ + 4; const size_t rowb = (size_t)b * SEQ, row0 = rowb + qb_ * 256;
                attn_body::bias_scan(lf + ((size_t)b * NFOX + h) * SEQ, NT * 64, (char*)lds);
                attn_body::attn_unit<true, 8, KVW, KVW, KVW, D>((const attn_body::bf16*)qb + row0 * KVW + 64 * h, (const attn_body::bf16*)kb + rowb * KVW + 64 * h,
                                              (const attn_body::bf16*)vb + rowb * KVW + 64 * h, (attn_body::bf16*)mix + row0 * D + 64 * h, NT, (char*)lds);
            }
        }
        for (int uidx = vcu; uidx < 256; uidx += G) { const int b = uidx >> 5, h = (uidx >> 3) & 3, qt = uidx & 7;
            const size_t row0 = (size_t)b * SEQ + qt * 256;
            attn_body::attn_unit<false, 8, MEMW, 1024, 1024, D>((const attn_body::bf16*)qmem + row0 * MEMW + 64 * h, (const attn_body::bf16*)memkv + (size_t)b * NMEM * 1024 + 512 + 64 * h,
                                           (const attn_body::bf16*)memkv + (size_t)b * NMEM * 1024 + 768 + 64 * h, (attn_body::bf16*)mix + row0 * D + TOK + 64 * h, 4, (char*)lds); }
    }
    SEAM(8);
    if (IN(9)) {
        pg8::Sched S; S.init(M, D, D, G, bx, mix, BWout);
        pg8::EpiRes E{xf, xf, xb, ss4};
        pg8::gemm_phase<pg8::EpiRes, false, false>(L, S, E);
    }
    SEAM(9);
    if (IN(10)) {
        pg8::Sched S; S.init(M, 2 * DFF, D, G, bx, xb, Bffi);
        pg8::EpiFfn E{gb, halo, ss4, in[25], in[26]};
        pg8::gemm_phase<pg8::EpiFfn, true, true>(L, S, E);
    }
    SEAM(10);
    if (IN(11)) fixup_phase(vcu, G, gb, halo, in[25], in[26]);
    SEAM(11);
    if (IN(12)) {
        pg8::Sched S; S.init(M, D, DFF, G, bx, gb, Bffo);
        pg8::EpiRes E{xf, xf, xb, ss4};
        pg8::gemm_phase<pg8::EpiRes, false, false>(L, S, E);
    }
    SEAM(12);
    if (IN(13)) final_phase(vcu, G, wave, lane, xf, ss4, in[28]);
#undef IN
#undef SEAM
#undef in
#undef xf
#undef Win
#undef Wmem
#undef AWout
#undef Affi
#undef Affo
#undef Kvq
#undef BWout
#undef Bffi
#undef Bffo
#undef xb
#undef mix
#undef memb
#undef memkv
#undef qmem
#undef ss4
#undef memss
#undef vssp
#undef lf
#undef halo
#undef zb
#undef gb
#undef kb
#undef vb
#undef qb
}

#ifndef MK_N_LAUNCHES
#define MK_N_LAUNCHES 1
#endif
static int mk_grid() {
    static int grid = 0;
    if (grid == 0) {
        int dev = 0, cus = 0, per_cu = 0;
        if (hipGetDevice(&dev) != hipSuccess || hipDeviceGetAttribute(&cus, hipDeviceAttributeMultiprocessorCount, dev) != hipSuccess) { fprintf(stderr, "kernel_launch: device query failed\n"); grid = -1; return grid; }
        if (hipFuncSetAttribute((const void*)mk_fwd, hipFuncAttributeMaxDynamicSharedMemorySize, LDS_BYTES) != hipSuccess) { fprintf(stderr, "kernel_launch: hipFuncSetAttribute failed\n"); grid = -1; return grid; }
        if (hipOccupancyMaxActiveBlocksPerMultiprocessor(&per_cu, (const void*)mk_fwd, NTHR, LDS_BYTES) != hipSuccess || per_cu < 1) { fprintf(stderr, "kernel_launch: occupancy query reports %d blocks per CU\n", per_cu); grid = -1; return grid; }
        (void)hipGetLastError();
        grid = cus;
    }
    return grid;
}
static void mk_launch(void* const* d_in, void* d_out, void* d_ws, hipStream_t stream, int nlaunch) {
    const int grid = mk_grid(); if (grid <= 0) return;
    (void)hipMemsetAsync((char*)d_ws + WS_CTL, 0, CTL_ZERO_BYTES, stream);
    Args a{};
    for (int i = 0; i < 29; ++i) a.in[i] = (const float*)d_in[i];
    a.out = (float*)d_out; a.ws = (unsigned char*)d_ws;
    if (nlaunch == 1) { a.ph_lo = 0; a.ph_hi = N_PHASES; hipLaunchKernelGGL(mk_fwd, dim3(grid), dim3(NTHR), LDS_BYTES, stream, a); }
    else for (int p = 0; p < N_PHASES; ++p) { a.ph_lo = p; a.ph_hi = p + 1; hipLaunchKernelGGL(mk_fwd, dim3(grid), dim3(NTHR), LDS_BYTES, stream, a); }
}

extern "C" void kernel_launch(void* const* d_in, const int* in_sizes, int n_in, void* d_out, int out_size, void* d_ws, size_t ws_size, hipStream_t stream) {
    if (n_in != 29 || out_size != M * D || ws_size < WS_END) { fprintf(stderr, "kernel_launch: unexpected sizes\n"); return; }
    mk_launch(d_in, d_out, d_ws, stream, MK_N_LAUNCHES);
}
```

```cpp
#define MK_N_LAUNCHES 1
#include <hip/hip_runtime.h>
#include <hip/hip_bf16.h>
#include <cstdio>
#include <cstdint>
#include <cmath>

#define LAS __attribute__((address_space(3)))
#define GAS __attribute__((address_space(1)))
typedef unsigned short bf16_t;
typedef short bf16x8 __attribute__((ext_vector_type(8)));
typedef float f32x4 __attribute__((ext_vector_type(4)));
typedef float f32x2 __attribute__((ext_vector_type(2)));
typedef float f32x16 __attribute__((ext_vector_type(16)));
typedef unsigned u32x4 __attribute__((ext_vector_type(4)));
typedef unsigned u32x2 __attribute__((ext_vector_type(2)));
typedef short s16x4 __attribute__((ext_vector_type(4)));

constexpr int NB = 8, SEQ = 2048, D = 1024, M = NB * SEQ, NMEM = 256, MROWS = NB * NMEM;
constexpr int TOK = 768, MEMW = 256, DFF = 2816, NFOX = 12, ZW = 1792, KVW = 768;
constexpr float EPS = 1e-6f;
constexpr float LOG2E = 1.4426950408889634f;
constexpr float C2 = 0.125f * LOG2E;
constexpr int NWAVES = 8, NTHR = 512;

constexpr size_t MiB = 1u << 20;
constexpr size_t WS_CTL = 0, CTL_ZERO_BYTES = 64 * 1024;
constexpr size_t WS_WIN = 1 * MiB;
constexpr size_t WS_WMEM = 5 * MiB;
constexpr size_t WS_AWOUT = 7 * MiB;
constexpr size_t WS_AFFI = 9 * MiB;
constexpr size_t WS_AFFO = 20 * MiB;
constexpr size_t WS_KVQ = 26 * MiB;
constexpr size_t WS_BWOUT = 32 * MiB;
constexpr size_t WS_BFFI = 34 * MiB;
constexpr size_t WS_BFFO = 45 * MiB;
constexpr size_t WS_XB = 51 * MiB;
constexpr size_t WS_MIX = 83 * MiB;
constexpr size_t WS_MEMB = 115 * MiB;
constexpr size_t WS_MEMKV = 119 * MiB;
constexpr size_t WS_SS4 = 123 * MiB;
constexpr size_t WS_MEMSS = 123 * MiB + 256 * 1024;
constexpr size_t WS_VSSP = 123 * MiB + 512 * 1024;
constexpr size_t WS_LF = 124 * MiB + 512 * 1024;
constexpr size_t WS_HALO = 126 * MiB;
constexpr size_t WS_R1 = 137 * MiB;
constexpr size_t WS_KB = WS_R1, WS_VB = WS_R1 + 24 * MiB, WS_QB = WS_R1 + 48 * MiB;
constexpr size_t WS_QMEM = 225 * MiB;
constexpr size_t WS_END = 233 * MiB;

constexpr int RING_BYTES = 131072;
constexpr int MISC_OFF = RING_BYTES;
constexpr int LDS_BYTES = 147456;

#define RLX_AGENT __ATOMIC_RELAXED, __HIP_MEMORY_SCOPE_AGENT
__device__ __forceinline__ unsigned f2bf(float f) { unsigned u = __builtin_bit_cast(unsigned, f); return (u + 0x7fffu + ((u >> 16) & 1u)) >> 16; }
__device__ __forceinline__ unsigned pk2(float lo, float hi) {
    typedef __bf16 bf2 __attribute__((ext_vector_type(2)));
    f32x2 v = {lo, hi}; bf2 b = __builtin_convertvector(v, bf2); return __builtin_bit_cast(unsigned, b); }
__device__ __forceinline__ float bf_lo(unsigned u) { return __builtin_bit_cast(float, u << 16); }
__device__ __forceinline__ float bf_hi(unsigned u) { return __builtin_bit_cast(float, u & 0xffff0000u); }
__device__ __forceinline__ float wave_sum(float v) {
#pragma unroll
    for (int o = 1; o < 64; o <<= 1) v += __shfl_xor(v, o);
    return v;
}
__device__ __forceinline__ float gelu_tanh(float x) {
    const float u = x * (0.7978845608028654f + 0.035677408136300125f * x * x);
    return x * __builtin_amdgcn_rcpf(1.0f + __builtin_amdgcn_exp2f(-2.0f * LOG2E * u));
}
__device__ __forceinline__ float silu_f(float x) { return x * __builtin_amdgcn_rcpf(1.0f + __builtin_amdgcn_exp2f(-LOG2E * x)); }
__device__ __forceinline__ float log_sigmoid_f(float x) { return x >= 0.f ? -log1pf(__expf(-x)) : x - log1pf(__expf(x)); }

#define XB_TMO      128
#define XB_XCNT(j)  (256  + 64 * (j))
#define XB_XSUB(j)  (1280 + 64 * (j))
#define XB_XGEN(j)  (2304 + 64 * (j))
#define XB_TOP      3328
#define XB_TOPGEN   3392
#define XCD_BAR_WORDS 3456
#define XB_SPIN_CAP (1u << 18)
__device__ __forceinline__ unsigned xb_ld(unsigned* p)              { return __hip_atomic_load(p, __ATOMIC_RELAXED, __HIP_MEMORY_SCOPE_AGENT); }
__device__ __forceinline__ unsigned xb_add(unsigned* p, unsigned v) { return __hip_atomic_fetch_add(p, v, __ATOMIC_RELAXED, __HIP_MEMORY_SCOPE_AGENT); }
__device__ __forceinline__ unsigned xb_xcc_id() { return (unsigned)__builtin_amdgcn_s_getreg((3 << 11) | 20) & 0xFu; }
#define XB_SPIN(cond, bar) do { unsigned _sp = 0; while (cond) { __builtin_amdgcn_s_sleep(1); \
    if ((++_sp & 255u) == 0u) { if (xb_ld(&(bar)[XB_TMO])) break; if (_sp > XB_SPIN_CAP) { atomicAdd(&(bar)[XB_TMO], 1u); break; } } } } while (0)
struct XcdBarrier { unsigned* bar; unsigned x; volatile LAS unsigned* st; };
__device__ __forceinline__ XcdBarrier xcd_barrier_post(unsigned* bar, volatile LAS unsigned* st) {
    XcdBarrier b; b.bar = bar; b.x = xb_xcc_id(); b.st = st;
    if (threadIdx.x == 0) (void)xb_add(&bar[XB_XCNT(b.x)], 1u);
    return b;
}
__device__ __forceinline__ void xcd_barrier_complete(unsigned* bar, unsigned x, unsigned& nloc, unsigned& nx) {
    const unsigned G = gridDim.x * gridDim.y * gridDim.z;
    unsigned sum, cnt, mine, sp = 0u;
    for (;;) {
        sum = 0u; cnt = 0u; mine = 0u;
#pragma unroll
        for (unsigned j = 0; j < 16; ++j) { const unsigned c = xb_ld(&bar[XB_XCNT(j)]); sum += c; cnt += (c > 0u) ? 1u : 0u; mine = (j == x) ? c : mine; }
        if (sum == G) break;
        __builtin_amdgcn_s_sleep(1);
        if ((++sp & 255u) == 0u) { if (xb_ld(&bar[XB_TMO])) break; if (sp > XB_SPIN_CAP) { atomicAdd(&bar[XB_TMO], 1u); break; } }
    }
    nloc = mine > 0u ? mine : 1u; nx = cnt > 0u ? cnt : 1u;
}
__device__ __forceinline__ void xcd_barrier(const XcdBarrier& b) {
    asm volatile("s_waitcnt vmcnt(0)" ::: "memory");
    __syncthreads();
    if (threadIdx.x == 0) {
        unsigned* bar = b.bar;
        __builtin_amdgcn_s_waitcnt(0);
        unsigned nloc = b.st[0], nx = b.st[1];
        if (nloc == 0u) { xcd_barrier_complete(bar, b.x, nloc, nx); b.st[0] = nloc; b.st[1] = nx; }
        const unsigned old = xb_add(&bar[XB_XSUB(b.x)], 1u);
        const unsigned gen = old / nloc;
        if (old + 1u == (gen + 1u) * nloc) {
            __builtin_amdgcn_fence(__ATOMIC_RELEASE, "agent");
            asm volatile("s_waitcnt vmcnt(0)" ::: "memory");
            const unsigned og = xb_add(&bar[XB_TOP], 1u);
            const unsigned tg = og / nx;
            if (og + 1u == (tg + 1u) * nx) xb_add(&bar[XB_TOPGEN], 1u);
            else XB_SPIN(xb_ld(&bar[XB_TOPGEN]) == tg, bar);
            __builtin_amdgcn_fence(__ATOMIC_ACQUIRE, "agent");
            xb_add(&bar[XB_XGEN(b.x)], 1u);
            asm volatile("s_waitcnt vmcnt(0)" ::: "memory");
        } else {
            XB_SPIN(xb_ld(&bar[XB_XGEN(b.x)]) == gen, bar);
            __builtin_amdgcn_fence(__ATOMIC_ACQUIRE, "agent");
            asm volatile("s_waitcnt vmcnt(0)" ::: "memory");
        }
    }
    __syncthreads();
}

namespace pg8 {
constexpr int BM = 256, BK = 64, HALF = 128, HTB = HALF * BK * 2, STAGE_BYTES = 8 * HTB, NXCD = 8, WGM = 8;
__host__ __device__ __forceinline__ int lds_byte(int r, int c) { const int st = (r >> 4) * 2 + (c >> 5), rr = r & 15, cc = c & 31, ob = rr * 64 + cc * 2; return st * 1024 + (ob ^ (((ob >> 9) & 1) << 5)); }
__host__ __device__ __forceinline__ void stage_rc(int b, int& R, int& C) { const int st = b / 1024, sb = b % 1024, swz = sb ^ (((sb >> 9) & 1) << 5); R = (st >> 1) * 16 + swz / 64; C = (st & 1) * 32 + (swz % 64) / 2; }
__host__ __device__ __forceinline__ int perm32(int rho) { const int n = rho >> 4, i = rho & 15; return 8 * (i >> 2) + 4 * n + (i & 3); }

struct Unit { int pm, pn, kind; };
struct Sched {
    int nM, nN, nwg, G, c, K; const bf16_t* A; const bf16_t* Bt;
    int nwg2, nM2; const bf16_t* A2; const bf16_t* Bt2;
    __device__ void init(int M_, int N_, int K_, int G_, int c_, const bf16_t* A_, const bf16_t* Bt_) { nM = M_ / BM; nN = N_ / BM; nwg = nM * nN; G = G_; c = c_; K = K_; A = A_; Bt = Bt_; nwg2 = 0; nM2 = 1; A2 = A_; Bt2 = Bt_; }
    __device__ void extra(int M2, int N2, const bf16_t* A2_, const bf16_t* Bt2_) { nM2 = M2 / BM; nwg2 = nM2 * (N2 / BM); A2 = A2_; Bt2 = Bt2_; }
    __device__ bool next(int i, Unit& u) const {
        const long L = (long)i * G + c;
        if (L >= nwg) { const long e = L - nwg; if (e >= nwg2) return false; u.pm = (int)(e % nM2); u.pn = (int)(e / nM2); u.kind = 1; return true; }
        int wgid = (int)L; { const int q = nwg / NXCD, r = nwg % NXCD, xcd = wgid % NXCD, off = wgid / NXCD; wgid = (xcd < r ? xcd * (q + 1) : r * (q + 1) + (xcd - r) * q) + off; }
        const int nig = WGM * nN, gid = wgid / nig, fm = gid * WGM, gsz = (nM - fm) < WGM ? (nM - fm) : WGM;
        u.pm = fm + ((wgid % nig) % gsz); u.pn = (wgid % nig) / gsz; u.kind = 0; return true;
    }
    __device__ __forceinline__ const char* a_ptr(const Unit& u) const { return (const char*)(u.kind ? A2 : A) + (size_t)u.pm * BM * K * 2; }
    __device__ __forceinline__ const char* b_ptr(const Unit& u) const { return (const char*)(u.kind ? Bt2 : Bt) + (size_t)u.pn * BM * K * 2; }
};

template <class Epi, bool ALIGN_EPI, bool A_PERM>
__device__ __forceinline__ void gemm_phase(LAS unsigned char* lds, const Sched& S, const Epi& E) {
    int tid = threadIdx.x; asm volatile("" : "+v"(tid));
    const int wid = __builtin_amdgcn_readfirstlane(tid >> 6), lane = tid & 63, wr = wid >> 2, wc = wid & 3, fr = lane & 15, fq = lane >> 4;
    const int K = S.K, nt = K / BK;
    unsigned voffA[2], voffB[2];
#pragma unroll
    for (int i = 0; i < 2; ++i) { int R, C; stage_rc(tid * 16 + i * 8192, R, C); const int Rb = (R & ~31) + perm32(R & 31);
        const int Ra = A_PERM ? (128 * (R >> 6) + 8 * (R & 15) + ((R >> 4) & 3)) : R;
        voffA[i] = (unsigned)(Ra * K + C) * 2u; voffB[i] = (unsigned)(Rb * K + C) * 2u; }
    const size_t kstep = (size_t)(BK * 2);
    const size_t hstepB = (size_t)HALF * K * 2;
    const size_t hstepA = A_PERM ? (size_t)4 * K * 2 : (size_t)HALF * K * 2;
    const unsigned ldsw = (unsigned)wid * 1024u;
    const int aoff = lds_byte(wr * 64 + fr, fq * 8), boff = lds_byte(wc * 32 + fr, fq * 8);
#define PG8_SA(b, h) (((b) * 2 + (h)) * HTB)
#define PG8_SB(b, h) ((4 + (b) * 2 + (h)) * HTB)
#define PG8_STAGE(bufoff, gbase, voff) do { _Pragma("unroll") for (int _i = 0; _i < 2; ++_i) \
        __builtin_amdgcn_global_load_lds((const unsigned*)((const char*)(gbase) + (voff)[_i]), (LAS unsigned*)(lds + (bufoff) + ldsw + _i * 8192), 16, 0, 0); } while (0)
#define PG8_LDA(dst, b, h) do { _Pragma("unroll") for (int m = 0; m < 4; ++m) _Pragma("unroll") for (int k = 0; k < 2; ++k) dst[m][k] = *(const LAS bf16x8*)(lds + PG8_SA(b, h) + aoff + m * 2048 + k * 1024); } while (0)
#define PG8_LDB(dst, b, h) do { _Pragma("unroll") for (int n = 0; n < 2; ++n) _Pragma("unroll") for (int k = 0; k < 2; ++k) dst[n][k] = *(const LAS bf16x8*)(lds + PG8_SB(b, h) + boff + n * 2048 + k * 1024); } while (0)
#define PG8_MMA(ai, bj, At, Bt) do { __builtin_amdgcn_s_setprio(1); _Pragma("unroll") for (int m = 0; m < 4; ++m) _Pragma("unroll") for (int n = 0; n < 2; ++n) _Pragma("unroll") for (int k = 0; k < 2; ++k) \
        acc[ai][bj][m][n] = __builtin_amdgcn_mfma_f32_16x16x32_bf16(Bt[n][k], At[m][k], acc[ai][bj][m][n], 0, 0, 0); __builtin_amdgcn_s_setprio(0); } while (0)
#define PG8_WAIT_V(n) asm volatile("s_waitcnt vmcnt(" #n ")" ::: "memory")
#define PG8_WAIT_L(n) asm volatile("s_waitcnt lgkmcnt(" #n ")" ::: "memory")
#define PG8_BAR __builtin_amdgcn_s_barrier()
#define PG8_SCHED __builtin_amdgcn_sched_barrier(0)
    Unit cur, nxt; int ui = 0;
    if (!S.next(0, cur)) return;
    f32x4 acc[2][2][4][2];
#pragma unroll
    for (int a = 0; a < 2; ++a)
#pragma unroll
        for (int b = 0; b < 2; ++b)
#pragma unroll
            for (int m = 0; m < 4; ++m)
#pragma unroll
                for (int n = 0; n < 2; ++n) acc[a][b][m][n] = (f32x4){0.f, 0.f, 0.f, 0.f};
    bf16x8 At[4][2], B0[2][2], B1[2][2];
    const char* cA = S.a_ptr(cur); const char* cB = S.b_ptr(cur);
    PG8_STAGE(PG8_SB(0, 0), cB, voffB); PG8_STAGE(PG8_SB(0, 1), cB + hstepB, voffB); PG8_STAGE(PG8_SA(0, 0), cA, voffA); PG8_STAGE(PG8_SA(0, 1), cA + hstepA, voffA);
    if (wr == 1) PG8_BAR;
    PG8_WAIT_V(2); PG8_BAR;
    PG8_STAGE(PG8_SB(1, 0), cB + kstep, voffB); PG8_STAGE(PG8_SA(1, 0), cA + kstep, voffA); PG8_STAGE(PG8_SB(1, 1), cB + hstepB + kstep, voffB);
    PG8_WAIT_V(6); PG8_BAR;
    for (;;) {
        const bool has_next = S.next(ui + 1, nxt);
        const char* nA = has_next ? S.a_ptr(nxt) : cA; const char* nB = has_next ? S.b_ptr(nxt) : cB;
        for (int t = 0; t < nt; t += 2) {
            const bool last = (t == nt - 2);
            const char* a1 = cA + (size_t)(t + 1) * kstep;
            const char* a2 = last ? nA : cA + (size_t)(t + 2) * kstep; const char* b2 = last ? nB : cB + (size_t)(t + 2) * kstep;
            const char* a3 = a2 + kstep; const char* b3 = b2 + kstep;
            PG8_LDB(B0, 0, 0); PG8_LDB(B1, 0, 1); PG8_SCHED; PG8_LDA(At, 0, 0); PG8_STAGE(PG8_SA(1, 1), a1 + hstepA, voffA);
            PG8_WAIT_V(8); PG8_WAIT_L(0); PG8_BAR; PG8_MMA(0, 0, At, B0); PG8_MMA(0, 1, At, B1); PG8_BAR; PG8_SCHED;
            PG8_LDA(At, 0, 1); PG8_STAGE(PG8_SB(0, 0), b2, voffB); PG8_STAGE(PG8_SB(0, 1), b2 + hstepB, voffB); PG8_STAGE(PG8_SA(0, 0), a2, voffA);
            PG8_WAIT_V(8); PG8_WAIT_L(0); PG8_BAR; PG8_MMA(1, 0, At, B0); PG8_MMA(1, 1, At, B1); PG8_BAR; PG8_SCHED;
            PG8_LDB(B0, 1, 0); PG8_LDB(B1, 1, 1); PG8_SCHED; PG8_LDA(At, 1, 0); PG8_STAGE(PG8_SA(0, 1), a2 + hstepA, voffA);
            PG8_WAIT_V(8); PG8_WAIT_L(0); PG8_BAR; PG8_MMA(0, 0, At, B0); PG8_MMA(0, 1, At, B1); PG8_BAR; PG8_SCHED;
            PG8_LDA(At, 1, 1); PG8_STAGE(PG8_SB(1, 0), b3, voffB); PG8_STAGE(PG8_SB(1, 1), b3 + hstepB, voffB); PG8_STAGE(PG8_SA(1, 0), a3, voffA);
            PG8_WAIT_V(8); PG8_WAIT_L(0); PG8_BAR; PG8_MMA(1, 0, At, B0); PG8_MMA(1, 1, At, B1); PG8_BAR; PG8_SCHED;
        }
        if constexpr (ALIGN_EPI) { if (wr == 0) PG8_BAR; }
        if constexpr (!Epi::AFTER_DRAIN) { E(acc, cur, wr, wc, fr, fq); }
        if (!has_next) break;
#pragma unroll
        for (int a = 0; a < 2; ++a)
#pragma unroll
            for (int b = 0; b < 2; ++b)
#pragma unroll
                for (int m = 0; m < 4; ++m)
#pragma unroll
                    for (int n = 0; n < 2; ++n) acc[a][b][m][n] = (f32x4){0.f, 0.f, 0.f, 0.f};
        cur = nxt; cA = nA; cB = nB; ++ui;
        if constexpr (ALIGN_EPI) { if (wr == 1) PG8_BAR; }
    }
    PG8_WAIT_V(0);
    if constexpr (!ALIGN_EPI) { if (wr == 0) PG8_BAR; }
    PG8_BAR;
    if constexpr (Epi::AFTER_DRAIN) { E.fused(acc, cur, wr, wc, fr, fq, lds, wid, lane); }
#undef PG8_SA
#undef PG8_SB
#undef PG8_STAGE
#undef PG8_LDA
#undef PG8_LDB
#undef PG8_MMA
#undef PG8_WAIT_V
#undef PG8_WAIT_L
#undef PG8_BAR
#undef PG8_SCHED
}
}

namespace pg8 {
__device__ __forceinline__ float rstd_of(const float* ss4, int row) { const f32x4 s = *(const f32x4*)(ss4 + (size_t)row * 4); return rsqrtf(((s[0] + s[1]) + (s[2] + s[3])) * (1.0f / D) + EPS); }

struct EpiIn {
    static constexpr bool AFTER_DRAIN = false;
    bf16_t* z; bf16_t* memkv; bf16_t* qmem; const float* ss4; const float* memss; float* vssp;
    __device__ __forceinline__ void operator()(const f32x4 (&acc)[2][2][4][2], const Unit& u, int wr, int wc, int fr, int fq) const {
        const bool main = (u.kind == 0), act = main && (u.pn < 6), vt = main && (u.pn >= 3) && (u.pn < 6);
        bf16_t* obase = main ? z : memkv; int ldc = main ? ZW : 1024;
        int col0 = u.pn * BM + wc * 32 + 8 * fq;
        if (main && u.pn == 6) { obase = qmem; ldc = MEMW; col0 -= 6 * BM; }
        const float* ssb = main ? ss4 : memss;
        float rsv[8];
#pragma unroll
        for (int j = 0; j < 8; ++j) rsv[j] = rstd_of(ssb, u.pm * BM + (j >> 2) * HALF + wr * 64 + (j & 3) * 16 + fr);
#pragma unroll
        for (int ai = 0; ai < 2; ++ai)
#pragma unroll
            for (int m = 0; m < 4; ++m) {
                const int row = u.pm * BM + ai * HALF + wr * 64 + m * 16 + fr;
                const float rs = rsv[ai * 4 + m];
                float sq = 0.f;
#pragma unroll
                for (int bj = 0; bj < 2; ++bj) {
                    f32x4 v0 = acc[ai][bj][m][0] * rs, v1 = acc[ai][bj][m][1] * rs;
                    if (act) {
#pragma unroll
                        for (int e = 0; e < 4; ++e) { v0[e] = gelu_tanh(v0[e]); v1[e] = gelu_tanh(v1[e]); }
                    }
                    sq += (v0[0] * v0[0] + v0[1] * v0[1]) + (v0[2] * v0[2] + v0[3] * v0[3]) + (v1[0] * v1[0] + v1[1] * v1[1]) + (v1[2] * v1[2] + v1[3] * v1[3]);
                    u32x4 w; w.x = pk2(v0[0], v0[1]); w.y = pk2(v0[2], v0[3]); w.z = pk2(v1[0], v1[1]); w.w = pk2(v1[2], v1[3]);
                    *(u32x4*)(obase + (size_t)row * ldc + col0 + bj * HALF) = w;
                }
                if (vt) { sq += __shfl_xor(sq, 16); sq += __shfl_xor(sq, 32); if (fq == 0) vssp[(size_t)row * 12 + (u.pn - 3) * 4 + wc] = sq; }
            }
    }
};

struct EpiKvq {
    static constexpr bool AFTER_DRAIN = false;
    bf16_t* kb; bf16_t* vb; bf16_t* qb; bf16_t* qmem; float* lf; const float* ss4; const float* b_f;
    __device__ __forceinline__ void operator()(const f32x4 (&acc)[2][2][4][2], const Unit& u, int wr, int wc, int fr, int fq) const {
        bf16_t* obase; int ldc, colt;
        if (u.pn < 3) { obase = kb; ldc = KVW; colt = u.pn * BM; } else if (u.pn < 6) { obase = vb; ldc = KVW; colt = (u.pn - 3) * BM; } else if (u.pn < 9) { obase = qb; ldc = KVW; colt = (u.pn - 6) * BM; } else { obase = qmem; ldc = MEMW; colt = 0; }
        const int col0 = colt + wc * 32 + 8 * fq;
        const bool ftile = (u.pn == 10);
        float rsv[8];
#pragma unroll
        for (int j = 0; j < 8; ++j) rsv[j] = rstd_of(ss4, u.pm * BM + (j >> 2) * HALF + wr * 64 + (j & 3) * 16 + fr);
#pragma unroll
        for (int ai = 0; ai < 2; ++ai)
#pragma unroll
            for (int m = 0; m < 4; ++m) {
                const int row = u.pm * BM + ai * HALF + wr * 64 + m * 16 + fr;
                const float rs = rsv[ai * 4 + m];
                if (!ftile) {
#pragma unroll
                    for (int bj = 0; bj < 2; ++bj) {
                        const f32x4 v0 = acc[ai][bj][m][0] * rs, v1 = acc[ai][bj][m][1] * rs;
                        u32x4 w; w.x = pk2(v0[0], v0[1]); w.y = pk2(v0[2], v0[3]); w.z = pk2(v1[0], v1[1]); w.w = pk2(v1[2], v1[3]);
                        *(u32x4*)(obase + (size_t)row * ldc + col0 + bj * HALF) = w;
                    }
                } else if (wc == 0 && fq < 2) {
                    const int b = row / SEQ, t = row % SEQ;
#pragma unroll
                    for (int n = 0; n < 2; ++n)
#pragma unroll
                        for (int e = 0; e < 4; ++e) { const int h = 8 * fq + 4 * n + e; if (h < NFOX) lf[((size_t)b * NFOX + h) * SEQ + t] = log_sigmoid_f(acc[ai][0][m][n][e] * rs + b_f[h]); }
                }
            }
    }
};

struct EpiRes {
    static constexpr bool AFTER_DRAIN = true;
    const float* R; float* xf; bf16_t* xb; float* ss4;
    __device__ __forceinline__ void fused(f32x4 (&acc)[2][2][4][2], const Unit& u, int wr, int wc, int fr, int fq, LAS unsigned char* lds, int wid, int lane) const {
        LAS float* P = (LAS float*)lds;
        const int col0 = u.pn * BM + wc * 32 + 8 * fq;
#pragma unroll
        for (int ai = 0; ai < 2; ++ai)
#pragma unroll
            for (int m = 0; m < 4; ++m) {
                const int rl = ai * HALF + wr * 64 + m * 16 + fr; const size_t off = (size_t)(u.pm * BM + rl) * D + col0;
                float sq = 0.f;
#pragma unroll
                for (int bj = 0; bj < 2; ++bj) {
                    const f32x4 r0 = *(const f32x4*)(R + off + bj * HALF), r1 = *(const f32x4*)(R + off + bj * HALF + 4);
                    const f32x4 v0 = acc[ai][bj][m][0] + r0, v1 = acc[ai][bj][m][1] + r1;
                    *(f32x4*)(xf + off + bj * HALF) = v0; *(f32x4*)(xf + off + bj * HALF + 4) = v1;
                    u32x4 w; w.x = pk2(v0[0], v0[1]); w.y = pk2(v0[2], v0[3]); w.z = pk2(v1[0], v1[1]); w.w = pk2(v1[2], v1[3]);
                    *(u32x4*)(xb + off + bj * HALF) = w;
                    sq += (v0[0] * v0[0] + v0[1] * v0[1]) + (v0[2] * v0[2] + v0[3] * v0[3]) + (v1[0] * v1[0] + v1[1] * v1[1]) + (v1[2] * v1[2] + v1[3] * v1[3]);
                }
                sq += __shfl_xor(sq, 16); sq += __shfl_xor(sq, 32);
                if (fq == 0) P[rl * 4 + wc] = sq;
            }
        __syncthreads();
        if (threadIdx.x < 256) { const int rl = threadIdx.x; const f32x4 p = *(const LAS f32x4*)(P + rl * 4); ss4[(size_t)(u.pm * BM + rl) * 4 + u.pn] = (p[0] + p[1]) + (p[2] + p[3]); }
        __syncthreads();
    }
};

__device__ __forceinline__ float dpp_shr1_f(float x) {
    int xi = __builtin_bit_cast(int, x);
    asm volatile("" : "+v"(xi));
    return __builtin_bit_cast(float, __builtin_amdgcn_update_dpp(0, xi, 0x111, 0xf, 0xf, true));
}
__device__ __forceinline__ f32x4 dpp_shr1(f32x4 v) { f32x4 r; r[0] = dpp_shr1_f(v[0]); r[1] = dpp_shr1_f(v[1]); r[2] = dpp_shr1_f(v[2]); r[3] = dpp_shr1_f(v[3]); return r; }
struct EpiFfn {
    static constexpr bool AFTER_DRAIN = false;
    bf16_t* g; float* halo; const float* ss4; const float* cw; const float* cb;
    __device__ __forceinline__ void operator()(f32x4 (&acc)[2][2][4][2], const Unit& u, int wr, int wc, int fr, int fq) const {
        const int T0 = u.pm * BM + wr * 128 + fr * 8;
        float rsv[8];
#pragma unroll
        for (int j = 0; j < 8; ++j) rsv[j] = rstd_of(ss4, T0 + j);
#pragma unroll
        for (int j = 0; j < 8; ++j) { const float r = rsv[j];
#pragma unroll
            for (int bj = 0; bj < 2; ++bj)
#pragma unroll
                for (int n = 0; n < 2; ++n) acc[j >> 2][bj][j & 3][n] *= r; }
        const int jc0 = u.pn * 128 + wc * 32 + 8 * fq;
        const int run = u.pm * 2 + wr;
        float* hrun = halo + (size_t)run * 4 * 5632 + u.pn * BM + wc * 32 + 8 * fq;
        unsigned pk[2][8][2];
#pragma unroll
        for (int n = 0; n < 2; ++n) {
            if (fr == 0) { *(f32x4*)(hrun + 4 * n) = acc[0][0][0][n]; *(f32x4*)(hrun + 5632 + 4 * n) = acc[0][0][1][n]; *(f32x4*)(hrun + HALF + 4 * n) = acc[0][1][0][n]; *(f32x4*)(hrun + 5632 + HALF + 4 * n) = acc[0][1][1][n]; }
            if (fr == 15) { *(f32x4*)(hrun + 2 * 5632 + 4 * n) = acc[1][0][2][n]; *(f32x4*)(hrun + 3 * 5632 + 4 * n) = acc[1][0][3][n]; *(f32x4*)(hrun + 2 * 5632 + HALF + 4 * n) = acc[1][1][2][n]; *(f32x4*)(hrun + 3 * 5632 + HALF + 4 * n) = acc[1][1][3][n]; }
        }
#pragma unroll
        for (int n = 0; n < 2; ++n) {
            const int cg = jc0 + 4 * n, cu = DFF + cg;
#pragma unroll
            for (int bj = 0; bj < 2; ++bj) {
                const int cc = bj ? cu : cg;
                const f32x4 w0 = *(const f32x4*)(cw + cc), w1 = *(const f32x4*)(cw + 5632 + cc), w2 = *(const f32x4*)(cw + 2 * 5632 + cc), bb = *(const f32x4*)(cb + cc);
                const f32x4 p1 = dpp_shr1(acc[1][bj][3][n]), p2 = dpp_shr1(acc[1][bj][2][n]);
#pragma unroll
                for (int j = 7; j >= 0; --j) {
                    const f32x4 h1 = j >= 1 ? acc[(j >= 1 ? j - 1 : 0) >> 2][bj][(j >= 1 ? j - 1 : 0) & 3][n] : p1;
                    const f32x4 h2 = j >= 2 ? acc[(j >= 2 ? j - 2 : 0) >> 2][bj][(j >= 2 ? j - 2 : 0) & 3][n] : (j == 1 ? p1 : p2);
                    acc[j >> 2][bj][j & 3][n] = bb + w2 * acc[j >> 2][bj][j & 3][n] + w1 * h1 + w0 * h2;
                }
            }
#pragma unroll
            for (int j = 0; j < 8; ++j) {
                const f32x4 cgv = acc[j >> 2][0][j & 3][n], cuv = acc[j >> 2][1][j & 3][n];
                f32x4 o;
#pragma unroll
                for (int e = 0; e < 4; ++e) o[e] = silu_f(cgv[e]) * cuv[e];
                pk[n][j][0] = pk2(o[0], o[1]); pk[n][j][1] = pk2(o[2], o[3]);
            }
        }
#pragma unroll
        for (int j = 0; j < 8; ++j) {
            u32x4 w; w.x = pk[0][j][0]; w.y = pk[0][j][1]; w.z = pk[1][j][0]; w.w = pk[1][j][1];
            *(u32x4*)(g + (size_t)(T0 + j) * DFF + jc0) = w;
        }
    }
};
}

__device__ __forceinline__ void fixup_phase(int vcu, int G, bf16_t* g, const float* halo, const float* cw, const float* cb) {
    for (int item = vcu; item < 256; item += G) {
        const int run = item >> 1, j = item & 1;
        if ((run & 15) == 0) continue;
        const float* hc = halo + (size_t)run * 4 * 5632; const float* hp = halo + (size_t)(run - 1) * 4 * 5632;
        for (int col = threadIdx.x; col < DFF; col += NTHR) {
            const int q = col >> 7, i = col & 127, ng = q * 256 + i, nu = ng + 128, cu = DFF + col;
            float r[2];
#pragma unroll
            for (int p = 0; p < 2; ++p) {
                const int nn = p ? nu : ng, cc = p ? cu : col;
                const float h0 = hc[nn], h1 = hc[5632 + nn], p2 = hp[2 * 5632 + nn], p3 = hp[3 * 5632 + nn];
                const float w0 = cw[cc], w1 = cw[5632 + cc], w2 = cw[2 * 5632 + cc], b = cb[cc];
                r[p] = (j == 0) ? (b + w2 * h0 + w1 * p3 + w0 * p2) : (b + w2 * h1 + w1 * h0 + w0 * p3);
            }
            g[(size_t)(run * 128 + j) * DFF + col] = (bf16_t)f2bf(silu_f(r[0]) * r[1]);
        }
    }
}

__device__ __forceinline__ void final_phase(int vcu, int G, int wave, int lane, float* xf, const float* ss4, const float* gain) {
    const int gw = vcu * NWAVES + wave, NGW = G * NWAVES;
    f32x4 gv[4];
#pragma unroll
    for (int j = 0; j < 4; ++j) gv[j] = *(const f32x4*)(gain + 4 * lane + 256 * j);
    for (int m = gw; m < M; m += NGW) {
        const float rs = pg8::rstd_of(ss4, m);
        f32x4* xr = (f32x4*)(xf + (size_t)m * D) + lane;
#pragma unroll
        for (int j = 0; j < 4; ++j) { const f32x4 v = xr[64 * j]; xr[64 * j] = v * rs * gv[j]; }
    }
}

struct TJob { const float* W; int ldw; int K; int ncols_valid; const float* gain; bf16_t* dst; };
__device__ __forceinline__ void transpose_item(const float* W, int ldw, int K, int k0, int srccol0, int ncols_valid, const float* gain, float scale, bf16_t* dst, int drow0, LAS float* scr, int lane) {
    const int n = lane & 31; const bool ok = (srccol0 + n) < ncols_valid;
#pragma unroll 8
    for (int i = 0; i < 32; ++i) { const int kk = 2 * i + (lane >> 5);
        float v = ok ? W[(size_t)(k0 + kk) * ldw + srccol0 + n] : 0.f;
        if (gain) v *= gain[k0 + kk];
        scr[kk * 33 + n] = v * scale; }
    asm volatile("s_waitcnt lgkmcnt(0)" ::: "memory");
    const int c = lane & 7;
#pragma unroll
    for (int j = 0; j < 4; ++j) { const int nn = (lane >> 3) + 8 * j; const LAS float* s = scr + (8 * c) * 33 + nn;
        u32x4 o; o.x = pk2(s[0 * 33], s[1 * 33]); o.y = pk2(s[2 * 33], s[3 * 33]); o.z = pk2(s[4 * 33], s[5 * 33]); o.w = pk2(s[6 * 33], s[7 * 33]);
        *(u32x4*)(dst + (size_t)(drow0 + nn) * K + k0 + 8 * c) = o; }
    asm volatile("s_waitcnt lgkmcnt(0)" ::: "memory");
}
__device__ __forceinline__ float row_to_bf16(const float* xrow, bf16_t* orow, int lane) {
    const f32x4* xr = (const f32x4*)xrow + lane;
    f32x4 v[4]; float s = 0.f;
#pragma unroll
    for (int j = 0; j < 4; ++j) { v[j] = xr[64 * j]; s += (v[j][0] * v[j][0] + v[j][1] * v[j][1]) + (v[j][2] * v[j][2] + v[j][3] * v[j][3]); }
    u32x2* o8 = (u32x2*)orow + lane;
#pragma unroll
    for (int j = 0; j < 4; ++j) { u32x2 w; w.x = pk2(v[j][0], v[j][1]); w.y = pk2(v[j][2], v[j][3]); o8[64 * j] = w; }
    return wave_sum(s);
}

namespace attn_body {
using bf16 = __hip_bfloat16;
constexpr int NW = 8, QBLK = 32, QB = QBLK * NW, KVBLK = 64;
__device__ __forceinline__ int crow(int r, int hi) { return (r & 3) + 8 * (r >> 2) + 4 * hi; }
#define SBAR() __builtin_amdgcn_sched_barrier(0)
__device__ __forceinline__ void cmask(f32x16& p0, f32x16& p1, int jb, int qrel, int hi) {
    const float NEG = -INFINITY; int kb = 64 * jb + 4 * hi;
#pragma unroll
    for (int r = 0; r < 16; ++r) { int kv = kb + (r & 3) + 8 * (r >> 2); if (kv > qrel) p0[r] = NEG; if (kv + 32 > qrel) p1[r] = NEG; }
}
constexpr int NSLOT = 3, SLOTB = 8192;
constexpr int LDS_K = 0, LDS_V = NSLOT * SLOTB, LDS_WS = 2 * NSLOT * SLOTB, LDS_OST = LDS_WS + NW * 64 * 4, LDS_ATT = LDS_OST + NW * 4096;
constexpr int LDS_BIAS = LDS_ATT, LDS_WTOT = LDS_BIAS + 8192, ATTN_LDS_BYTES = LDS_WTOT + 64;
__device__ __forceinline__ void glds16(const void* gsrc, unsigned lds_dst) { unsigned keep;
    asm volatile("s_mov_b32 %0, m0\n\ts_mov_b32 m0, %2\n\ts_nop 0\n\tglobal_load_lds_dwordx4 %1, off\n\ts_mov_b32 m0, %0" : "=&s"(keep) : "v"(gsrc), "s"(lds_dst) : "memory"); }
#define WAIT_BAR(N) asm volatile("s_waitcnt vmcnt(" #N ") lgkmcnt(0)\n\ts_barrier" ::: "memory")
typedef __attribute__((address_space(3))) const char* lds_cptr;
typedef short v4i16_t __attribute__((ext_vector_type(4)));
__device__ __forceinline__ void kload8(bf16x8* kf, lds_cptr kp) {
    kf[0] = *(const LAS bf16x8*)(kp);        kf[1] = *(const LAS bf16x8*)(kp + 512);
    kf[2] = *(const LAS bf16x8*)(kp + 2048); kf[3] = *(const LAS bf16x8*)(kp + 2560);
    kf[4] = *(const LAS bf16x8*)(kp + 4096); kf[5] = *(const LAS bf16x8*)(kp + 4608);
    kf[6] = *(const LAS bf16x8*)(kp + 6144); kf[7] = *(const LAS bf16x8*)(kp + 6656);
}
__device__ __forceinline__ void kload2(bf16x8* kf, lds_cptr kp, int j) { kf[2 * j] = *(const LAS bf16x8*)(kp + j * 2048); kf[2 * j + 1] = *(const LAS bf16x8*)(kp + j * 2048 + 512); }
__device__ __forceinline__ s16x4 vtr(lds_cptr p) { return __builtin_bit_cast(s16x4, __builtin_amdgcn_ds_read_tr16_b64_v4i16((LAS v4i16_t*)p)); }
#define MX3(a, b, c) __builtin_fmaxf(__builtin_fmaxf((a), (b)), (c))
__device__ __forceinline__ float rowmax(const f32x16& p0, const f32x16& p1) {
    float a = MX3(p0[0], p0[1], p1[0]), b = MX3(p0[2], p0[3], p1[1]); a = MX3(a, p1[2], p1[3]);
#pragma unroll
    for (int r = 4; r < 16; r += 4) { a = MX3(a, p0[r], p0[r + 1]); b = MX3(b, p0[r + 2], p0[r + 3]); a = MX3(a, p1[r], p1[r + 1]); b = MX3(b, p1[r + 2], p1[r + 3]); }
    float m = __builtin_fmaxf(a, b); auto rr = __builtin_amdgcn_permlane32_swap(__float_as_uint(m), __float_as_uint(m), false, false);
    return __builtin_fmaxf(__uint_as_float(rr[0]), __uint_as_float(rr[1]));
}
__device__ __forceinline__ void pv(f32x16* o, int vb, bf16x8 pa0, bf16x8 pa1, bf16x8 pa2, bf16x8 pa3) {
#pragma unroll
    for (int d0 = 0; d0 < 2; ++d0) { s16x4 lo[4], hi[4];
#pragma unroll
        for (int ks = 0; ks < 4; ++ks) {
            asm volatile("ds_read_b64_tr_b16 %0,%1 offset:%c2" : "=&v"(lo[ks]) : "v"(vb), "i"(d0 * 4096 + ks * 1024) : "memory");
            asm volatile("ds_read_b64_tr_b16 %0,%1 offset:%c2" : "=&v"(hi[ks]) : "v"(vb), "i"(d0 * 4096 + ks * 1024 + 512) : "memory"); }
        asm volatile("s_waitcnt lgkmcnt(0)" ::: "memory"); SBAR();
#define PK(k) (bf16x8){lo[k][0], lo[k][1], lo[k][2], lo[k][3], hi[k][0], hi[k][1], hi[k][2], hi[k][3]}
        o[d0] = __builtin_amdgcn_mfma_f32_32x32x16_bf16(pa0, PK(0), o[d0], 0, 0, 0);
        o[d0] = __builtin_amdgcn_mfma_f32_32x32x16_bf16(pa1, PK(1), o[d0], 0, 0, 0);
        o[d0] = __builtin_amdgcn_mfma_f32_32x32x16_bf16(pa2, PK(2), o[d0], 0, 0, 0);
        o[d0] = __builtin_amdgcn_mfma_f32_32x32x16_bf16(pa3, PK(3), o[d0], 0, 0, 0);
#undef PK
    }
}

template <bool FOX, int THRL, int qp, int kp, int vp, int op>
__device__ __forceinline__ void attn_unit(const bf16* Q, const bf16* __restrict__ K, const bf16* __restrict__ V, bf16* O, int NT, char* shm) {
    int tid = threadIdx.x; asm volatile("" : "+v"(tid));
    const int lane = tid & 63, r32 = lane & 31, hi = lane >> 5; const int wid = __builtin_amdgcn_readfirstlane(tid >> 6);
    const bf16* Qw = Q + (long)(wid * QBLK) * qp;
    const unsigned lds0 = (unsigned)(uintptr_t)shm;
    float* wsf = (float*)(shm + LDS_WS) + wid * 64;
    const bf16* ksrc = K + (long)lane * kp + wid * 8;
    const bf16* vsrc = V + (long)(16 * (wid & 3) + (lane >> 2)) * vp + (wid >> 2) * 32 + (lane & 3) * 8;
    const unsigned kdst = lds0 + LDS_K + wid * 1024, vdst = lds0 + LDS_V + wid * 1024;
#define DMA_K(t, slot) glds16(ksrc + (long)(t) * KVBLK * kp, (unsigned)__builtin_amdgcn_readfirstlane(kdst + (slot)))
#define DMA_V(t, slot) glds16(vsrc + (long)(t) * KVBLK * vp, (unsigned)__builtin_amdgcn_readfirstlane(vdst + (slot)))
    const int vb0 = (int)(lds0 + LDS_V) + ((lane >> 4) & 1) * 32 + (lane & 3) * 8 + (4 * hi + ((lane & 15) >> 2)) * 64;
    const char* Kbase = shm + LDS_K; bf16x8 kf[8];
    const lds_cptr shm3 = (lds_cptr)shm; const lds_cptr kp0 = shm3 + LDS_K + hi * 1024 + r32 * 16; const lds_cptr vp0 = shm3 + LDS_V + ((lane >> 4) & 1) * 32 + (lane & 3) * 8 + (4 * hi + ((lane & 15) >> 2)) * 64;
    const LAS float* biasL = (const LAS float*)(shm3 + LDS_BIAS) + 4 * hi;
    DMA_K(0, 0); DMA_V(0, 0); DMA_K(1, SLOTB);
    bf16x8 qr[4];
#pragma unroll
    for (int d0 = 0; d0 < 4; ++d0) qr[d0] = *reinterpret_cast<const bf16x8*>(&Qw[(long)r32 * qp + d0 * 16 + hi * 8]);
    const int qrel = wid * QBLK + r32;
    float mhat = 0.f, l_reg = 0.f; f32x16 o[2]; o[0] = f32x16{}; o[1] = f32x16{};
    float sq = 0.f;
    if (FOX) sq = -((const LAS float*)(shm3 + LDS_BIAS))[(NT - 4) * KVBLK + qrel];
    bool resc = false;
#define CINIT(C0, C1, t) do { if (FOX) { const LAS float* bp_ = biasL + (t) * KVBLK; \
        _Pragma("unroll") for (int a_ = 0; a_ < 4; ++a_) { const f32x4 b0_ = *(const LAS f32x4*)(bp_ + 8 * a_), b1_ = *(const LAS f32x4*)(bp_ + 32 + 8 * a_); \
            _Pragma("unroll") for (int e_ = 0; e_ < 4; ++e_) { C0[4 * a_ + e_] = b0_[e_] + sq; C1[4 * a_ + e_] = b1_[e_] + sq; } } } \
      else { _Pragma("unroll") for (int r_ = 0; r_ < 16; ++r_) { C0[r_] = sq; C1[r_] = sq; } } } while (0)
#define DECIDE(C0, C1) do { float rm = rowmax(C0, C1); resc = false; \
      if (__builtin_expect(__any(rm > (float)THRL), 0)) { const float dl = __builtin_fmaxf(rm, 0.f); mhat += dl; sq -= dl; \
        _Pragma("unroll") for (int r = 0; r < 16; ++r) { C0[r] -= dl; C1[r] -= dl; } \
        const float f = __builtin_amdgcn_exp2f(-dl); l_reg *= f; if (hi == 0) wsf[r32] = f; resc = true; } } while (0)
#define RESC() do { if (resc) { asm volatile("s_waitcnt lgkmcnt(0)" ::: "memory"); \
      _Pragma("unroll") for (int d_ = 0; d_ < 2; ++d_) _Pragma("unroll") for (int r = 0; r < 16; ++r) o[d_][r] *= wsf[crow(r, hi)]; } } while (0)
#define CMASK(P0, P1, t) do { if (FOX) { int jb_ = (t) - (NT - 4); if (jb_ >= 0) cmask(P0, P1, jb_, qrel, hi); } } while (0)
    f32x16 pA0, pA1, pB0, pB1;
    int sl_prev = 0, sl_cur = 0, sl_next = SLOTB;
#define ROT() do { sl_prev = sl_cur; sl_cur = sl_next; sl_next = (sl_next == (NSLOT - 1) * SLOTB) ? 0 : sl_next + SLOTB; } while (0)
    DMA_K(2, 2 * SLOTB);
    WAIT_BAR(3);
    CINIT(pA0, pA1, 0);
    {
        const char* kb = Kbase + hi * 1024 + r32 * 16;
#pragma unroll
        for (int d0 = 0; d0 < 4; ++d0) {
            const bf16x8 b0 = *reinterpret_cast<const bf16x8*>(kb + d0 * 2048);
            const bf16x8 b1 = *reinterpret_cast<const bf16x8*>(kb + d0 * 2048 + 512);
            pA0 = __builtin_amdgcn_mfma_f32_32x32x16_bf16(b0, qr[d0], pA0, 0, 0, 0); pA1 = __builtin_amdgcn_mfma_f32_32x32x16_bf16(b1, qr[d0], pA1, 0, 0, 0); }
    }
    CMASK(pA0, pA1, 0);
    DECIDE(pA0, pA1);
#pragma unroll
    for (int r = 0; r < 16; ++r) { pA0[r] = __builtin_amdgcn_exp2f(pA0[r]); pA1[r] = __builtin_amdgcn_exp2f(pA1[r]); }
    WAIT_BAR(0);
    DMA_K(3, 0); DMA_V(1, SLOTB);
    ROT();
    kload8(kf, kp0 + sl_cur);
    WAIT_BAR(2);
    s16x4 vlo[8], vhi[8]; u32x4 pw0, pw1, pw2, pw3;
#define PKW(P, B) pk2(P[B], P[B + 1])
#define PAF(k) __builtin_bit_cast(bf16x8, pw##k)
#define VFR(i) (bf16x8){vlo[i][0], vlo[i][1], vlo[i][2], vlo[i][3], vhi[i][0], vhi[i][1], vhi[i][2], vhi[i][3]}
#define PIN(x) asm volatile("" : "+v"(x))
#define GAPA(MF, A0, A1, A2, A3, W0, W1, PW) do { MF; sacc += A0; sacc += A1; sacc += A2; sacc += A3; PIN(sacc); W0; W1; PIN(PW); SBAR(); } while (0)
#define EX(v) __builtin_amdgcn_exp2f(v)
#define GAPB(MF, X, B) do { MF; X[B] = EX(X[B]); X[B + 1] = EX(X[B + 1]); X[B + 2] = EX(X[B + 2]); X[B + 3] = EX(X[B + 3]); PIN(X); SBAR(); } while (0)
#define VRD(i) do { vlo[i] = vtr(vp_ + (((i) >> 2) * 4096 + ((i) & 3) * 1024)); vhi[i] = vtr(vp_ + (((i) >> 2) * 4096 + ((i) & 3) * 1024 + 512)); } while (0)
#define KRD(G, j) do { if (G) { kload2(kf, kp0 + sl_next, j); SBAR(); } } while (0)
#define STEP(C0, C1, P0, P1, t, GK, GV, GL) do { SBAR(); \
    const lds_cptr vp_ = vp0 + sl_prev; \
    CINIT(C0, C1, t); SBAR(); \
    VRD(0); SBAR(); float sacc = (P0[0] + P0[1]); \
    GAPA(C0 = __builtin_amdgcn_mfma_f32_32x32x16_bf16(kf[0], qr[0], C0, 0, 0, 0), P0[2], P0[3], P0[4], P0[5],     pw0[0] = PKW(P0, 0), pw0[1] = PKW(P0, 2), pw0); \
    VRD(4); SBAR(); GAPA(C1 = __builtin_amdgcn_mfma_f32_32x32x16_bf16(kf[1], qr[0], C1, 0, 0, 0), P0[6], P0[7], P0[8], P0[9],     pw0[2] = PKW(P0, 4), pw0[3] = PKW(P0, 6), pw0); \
    VRD(1); SBAR(); GAPA(C0 = __builtin_amdgcn_mfma_f32_32x32x16_bf16(kf[2], qr[1], C0, 0, 0, 0),   P0[10], P0[11], P0[12], P0[13], pw1[0] = PKW(P0, 8), pw1[1] = PKW(P0, 10), pw1); \
    VRD(5); SBAR(); GAPA(C1 = __builtin_amdgcn_mfma_f32_32x32x16_bf16(kf[3], qr[1], C1, 0, 0, 0),   P0[14], P0[15], P1[0], P1[1],   pw1[2] = PKW(P0, 12), pw1[3] = PKW(P0, 14), pw1); \
    VRD(2); SBAR(); GAPA(C0 = __builtin_amdgcn_mfma_f32_32x32x16_bf16(kf[4], qr[2], C0, 0, 0, 0),   P1[2], P1[3], P1[4], P1[5],     pw2[0] = PKW(P1, 0), pw2[1] = PKW(P1, 2), pw2); \
    VRD(6); SBAR(); GAPA(C1 = __builtin_amdgcn_mfma_f32_32x32x16_bf16(kf[5], qr[2], C1, 0, 0, 0),   P1[6], P1[7], P1[8], P1[9],     pw2[2] = PKW(P1, 4), pw2[3] = PKW(P1, 6), pw2); \
    VRD(3); SBAR(); GAPA(C0 = __builtin_amdgcn_mfma_f32_32x32x16_bf16(kf[6], qr[3], C0, 0, 0, 0),   P1[10], P1[11], P1[12], P1[13], pw3[0] = PKW(P1, 8), pw3[1] = PKW(P1, 10), pw3); \
    VRD(7); SBAR(); GAPA(C1 = __builtin_amdgcn_mfma_f32_32x32x16_bf16(kf[7], qr[3], C1, 0, 0, 0),   P1[14], P1[15], 0.f, 0.f,       pw3[2] = PKW(P1, 12), pw3[3] = PKW(P1, 14), pw3); \
    l_reg += sacc; \
    if (GK) { DMA_K((t) + 3, sl_cur); } if (GV) { DMA_V((t) + 1, sl_next); } \
    CMASK(C0, C1, t); \
    DECIDE(C0, C1); \
    SBAR(); \
    GAPB(o[0] = __builtin_amdgcn_mfma_f32_32x32x16_bf16(PAF(0), VFR(0), o[0], 0, 0, 0), C0, 0); \
    GAPB(o[1] = __builtin_amdgcn_mfma_f32_32x32x16_bf16(PAF(0), VFR(4), o[1], 0, 0, 0), C0, 4); \
    KRD(GL, 0); GAPB(o[0] = __builtin_amdgcn_mfma_f32_32x32x16_bf16(PAF(1), VFR(1), o[0], 0, 0, 0), C0, 8); \
    KRD(GL, 1); GAPB(o[1] = __builtin_amdgcn_mfma_f32_32x32x16_bf16(PAF(1), VFR(5), o[1], 0, 0, 0), C0, 12); \
    KRD(GL, 2); GAPB(o[0] = __builtin_amdgcn_mfma_f32_32x32x16_bf16(PAF(2), VFR(2), o[0], 0, 0, 0), C1, 0); \
    KRD(GL, 3); GAPB(o[1] = __builtin_amdgcn_mfma_f32_32x32x16_bf16(PAF(2), VFR(6), o[1], 0, 0, 0), C1, 4); \
    GAPB(o[0] = __builtin_amdgcn_mfma_f32_32x32x16_bf16(PAF(3), VFR(3), o[0], 0, 0, 0), C1, 8); \
    GAPB(o[1] = __builtin_amdgcn_mfma_f32_32x32x16_bf16(PAF(3), VFR(7), o[1], 0, 0, 0), C1, 12); \
    } while (0)
    int t = 1;
    for (; t + 5 < NT; t += 2) {
        STEP(pB0, pB1, pA0, pA1, t, true, true, true);     WAIT_BAR(2); RESC(); ROT();
        STEP(pA0, pA1, pB0, pB1, t + 1, true, true, true); WAIT_BAR(2); RESC(); ROT();
    }
#define ENDW(tt) do { if ((tt) + 3 < NT) { WAIT_BAR(2); } else if ((tt) + 2 < NT) { WAIT_BAR(1); } else { WAIT_BAR(0); } } while (0)
    for (; t + 1 < NT; t += 2) {
        STEP(pB0, pB1, pA0, pA1, t, (t + 3 < NT), (t + 1 < NT), (t + 1 < NT));       ENDW(t);     RESC(); ROT();
        STEP(pA0, pA1, pB0, pB1, t + 1, (t + 4 < NT), (t + 2 < NT), (t + 2 < NT));   ENDW(t + 1); RESC(); ROT();
    }
    STEP(pB0, pB1, pA0, pA1, NT - 1, false, false, false); RESC();
    { float sacc = pB0[0] + pB0[1];
#pragma unroll
      for (int r = 2; r < 16; ++r) sacc += pB0[r];
#pragma unroll
      for (int r = 0; r < 16; ++r) sacc += pB1[r];
      l_reg += sacc;
      pw0 = (u32x4){PKW(pB0, 0), PKW(pB0, 2), PKW(pB0, 4), PKW(pB0, 6)}; pw1 = (u32x4){PKW(pB0, 8), PKW(pB0, 10), PKW(pB0, 12), PKW(pB0, 14)};
      pw2 = (u32x4){PKW(pB1, 0), PKW(pB1, 2), PKW(pB1, 4), PKW(pB1, 6)}; pw3 = (u32x4){PKW(pB1, 8), PKW(pB1, 10), PKW(pB1, 12), PKW(pB1, 14)};
      SBAR(); pv(o, vb0 + sl_cur, PAF(0), PAF(1), PAF(2), PAF(3)); }
    { auto rr = __builtin_amdgcn_permlane32_swap(__float_as_uint(l_reg), __float_as_uint(l_reg), false, false); l_reg = __uint_as_float(rr[0]) + __uint_as_float(rr[1]); }
    if (hi == 0) wsf[32 + r32] = l_reg; asm volatile("s_waitcnt lgkmcnt(0)" ::: "memory");
    float rli[16];
#pragma unroll
    for (int r = 0; r < 16; ++r) rli[r] = __builtin_amdgcn_rcpf(wsf[32 + crow(r, hi)]);
    bf16* Ow = O + (long)(wid * QBLK) * op;
    { bf16* stg = (bf16*)(shm + LDS_OST) + wid * 2048;
#pragma unroll
      for (int r = 0; r < 16; ++r) { const int orow = crow(r, hi);
#pragma unroll
          for (int d0 = 0; d0 < 2; ++d0) stg[orow * 64 + d0 * 32 + r32] = __float2bfloat16(o[d0][r] * rli[r]); }
      asm volatile("s_waitcnt lgkmcnt(0)" ::: "memory");
#pragma unroll
      for (int i = 0; i < 4; ++i) { const int row = i * 8 + (lane >> 3), ch = lane & 7; const u32x4 v = *(const u32x4*)(stg + row * 64 + ch * 8); *(u32x4*)(Ow + (long)row * op + ch * 8) = v; } }
    asm volatile("s_waitcnt lgkmcnt(0)\n\ts_barrier" ::: "memory");
#undef DMA_K
#undef DMA_V
#undef CINIT
#undef DECIDE
#undef RESC
#undef CMASK
#undef ROT
#undef PKW
#undef PAF
#undef VFR
#undef PIN
#undef GAPA
#undef GAPB
#undef EX
#undef VRD
#undef KRD
#undef STEP
#undef ENDW
}

__device__ __forceinline__ void bias_scan(const float* lf, int n, char* shm) {
    int tid = threadIdx.x; asm volatile("" : "+v"(tid));
    const int lane = tid & 63, wid = tid >> 6;
    LAS float* bias = (LAS float*)((lds_cptr)shm + LDS_BIAS); LAS float* wtot = (LAS float*)((lds_cptr)shm + LDS_WTOT);
    f32x4 v = (f32x4){0.f, 0.f, 0.f, 0.f};
    if (4 * tid < n) v = *(const f32x4*)(lf + 4 * tid);
    v[1] += v[0]; v[2] += v[1]; v[3] += v[2];
    float s = v[3];
#pragma unroll
    for (int o = 1; o < 64; o <<= 1) { const float u = __shfl_up(s, o); if (lane >= o) s += u; }
    if (lane == 63) wtot[wid] = s;
    __syncthreads();
    float base = s - v[3];
    for (int w = 0; w < wid; ++w) base += wtot[w];
    if (4 * tid < n) { f32x4 r; r[0] = -(base + v[0]) * LOG2E; r[1] = -(base + v[1]) * LOG2E; r[2] = -(base + v[2]) * LOG2E; r[3] = -(base + v[3]) * LOG2E; *(LAS f32x4*)(bias + 4 * tid) = r; }
    __syncthreads();
}
#undef SBAR
#undef WAIT_BAR
#undef MX3
}

constexpr int GM_VSTRIDE = 416;
constexpr int GM_RSTD_OFF = 128 * GM_VSTRIDE;
__device__ __forceinline__ void gmlp_unit(int b, int n, int g, const bf16_t* z, const float* vssp, const float* w_s, const float* b_s, const float* vgain, bf16_t* mix, char* shm) {
    typedef __attribute__((address_space(3))) char* lds_ptr;
    int tid = threadIdx.x; asm volatile("" : "+v"(tid));
    const int lane = tid & 63, fr = lane & 15, fq = lane >> 4; const int wid = __builtin_amdgcn_readfirstlane(tid >> 6);
    const int t0 = b * SEQ + n * 128;
    lds_ptr sh = (lds_ptr)shm; LAS float* rstd = (LAS float*)(sh + GM_RSTD_OFF);
#pragma unroll
    for (int i = 0; i < 6; ++i) { const int idx = tid + NTHR * i, row = idx / 24, ch = idx % 24;
        const u32x4 w = *(const u32x4*)(z + (size_t)(t0 + row) * ZW + TOK + 192 * g + ch * 8);
        const int p = ch >> 2, a = ch & 3; lds_ptr dst = sh + row * GM_VSTRIDE + p * 64 + a * 8;
        *(LAS u32x2*)(dst) = (u32x2){w.x, w.y}; *(LAS u32x2*)(dst + 32) = (u32x2){w.z, w.w}; }
    if (tid < 128) { const float* p = vssp + (size_t)(t0 + tid) * 12; float s = 0.f;
#pragma unroll
        for (int i = 0; i < 12; ++i) s += p[i];
        rstd[tid] = rsqrtf(s * (1.0f / TOK) + EPS); }
    __syncthreads();
    f32x4 acc[12];
#pragma unroll
    for (int i = 0; i < 12; ++i) acc[i] = (f32x4){0.f, 0.f, 0.f, 0.f};
    const int trow = 16 * wid + fr;
    const int nks = (wid >> 1) + 1;
    const float* wrow = w_s + ((size_t)g * 128 + trow) * 128;
    for (int ks = 0; ks < nks; ++ks) {
        const int s0 = 32 * ks + 4 * fq;
        const f32x4 w0 = *(const f32x4*)(wrow + s0), w1 = *(const f32x4*)(wrow + s0 + 16);
        const f32x4 r0 = *(const LAS f32x4*)(rstd + s0), r1 = *(const LAS f32x4*)(rstd + s0 + 16);
        float wv[8];
#pragma unroll
        for (int e = 0; e < 4; ++e) { wv[e] = (s0 + e <= trow) ? w0[e] * r0[e] : 0.f; wv[4 + e] = (s0 + 16 + e <= trow) ? w1[e] * r1[e] : 0.f; }
        u32x4 wp; wp.x = pk2(wv[0], wv[1]); wp.y = pk2(wv[2], wv[3]); wp.z = pk2(wv[4], wv[5]); wp.w = pk2(wv[6], wv[7]);
        const bf16x8 wfrag = __builtin_bit_cast(bf16x8, wp);
        lds_ptr vbase = sh + (32 * ks + 4 * fq + (fr >> 2)) * GM_VSTRIDE + (fr & 3) * 8;
#pragma unroll
        for (int nb = 0; nb < 12; ++nb) {
            const s16x4 lo = __builtin_bit_cast(s16x4, __builtin_amdgcn_ds_read_tr16_b64_v4i16((LAS attn_body::v4i16_t*)(vbase + (nb >> 1) * 64 + (nb & 1) * 32)));
            const s16x4 hi = __builtin_bit_cast(s16x4, __builtin_amdgcn_ds_read_tr16_b64_v4i16((LAS attn_body::v4i16_t*)(vbase + 16 * GM_VSTRIDE + (nb >> 1) * 64 + (nb & 1) * 32)));
            const bf16x8 vfrag = (bf16x8){lo[0], lo[1], lo[2], lo[3], hi[0], hi[1], hi[2], hi[3]};
            acc[nb] = __builtin_amdgcn_mfma_f32_16x16x32_bf16(vfrag, wfrag, acc[nb], 0, 0, 0);
        }
    }
    const float bs = b_s[g * 128 + trow];
    const size_t rowoff = (size_t)(t0 + trow);
#pragma unroll
    for (int p = 0; p < 6; ++p) {
        const int c0 = 192 * g + 32 * p + 8 * fq;
        const f32x4 g0 = *(const f32x4*)(vgain + c0), g1 = *(const f32x4*)(vgain + c0 + 4);
        const u32x4 uu = *(const u32x4*)(z + rowoff * ZW + c0);
        f32x4 m0 = acc[2 * p] * g0 + bs, m1 = acc[2 * p + 1] * g1 + bs;
        u32x4 w; w.x = pk2(bf_lo(uu.x) * m0[0], bf_hi(uu.x) * m0[1]); w.y = pk2(bf_lo(uu.y) * m0[2], bf_hi(uu.y) * m0[3]);
        w.z = pk2(bf_lo(uu.z) * m1[0], bf_hi(uu.z) * m1[1]); w.w = pk2(bf_lo(uu.w) * m1[2], bf_hi(uu.w) * m1[3]);
        *(u32x4*)(mix + rowoff * D + c0) = w;
    }
    __syncthreads();
}

constexpr int N_PHASES = 14;
#ifndef MK_DBG_PTR
#define MK_DBG_PTR nullptr
#endif
struct Args { const float* in[29]; float* out; unsigned char* ws; int ph_lo, ph_hi; };

__global__ void __launch_bounds__(NTHR, 2) mk_fwd(Args args) {
    extern __shared__ __attribute__((aligned(16))) unsigned char lds[];
    LAS unsigned char* L = (LAS unsigned char*)lds;
    volatile LAS unsigned* MISC = (volatile LAS unsigned*)(L + MISC_OFF);
    const int tid = threadIdx.x, lane = tid & 63, wave = __builtin_amdgcn_readfirstlane(tid >> 6);
    const int G = gridDim.x; const int bx = blockIdx.x; const int vcu = (G % 8 == 0) ? (bx % 8) * (G / 8) + bx / 8 : bx;
    unsigned char* ws = args.ws;
#define in args.in
#define xf args.out
#define P_BF(off) ((bf16_t*)(ws + (off)))
#define P_F32(off) ((float*)(ws + (off)))
#define Win P_BF(WS_WIN)
#define Wmem P_BF(WS_WMEM)
#define AWout P_BF(WS_AWOUT)
#define Affi P_BF(WS_AFFI)
#define Affo P_BF(WS_AFFO)
#define Kvq P_BF(WS_KVQ)
#define BWout P_BF(WS_BWOUT)
#define Bffi P_BF(WS_BFFI)
#define Bffo P_BF(WS_BFFO)
#define xb P_BF(WS_XB)
#define mix P_BF(WS_MIX)
#define memb P_BF(WS_MEMB)
#define memkv P_BF(WS_MEMKV)
#define qmem P_BF(WS_QMEM)
#define ss4 P_F32(WS_SS4)
#define memss P_F32(WS_MEMSS)
#define vssp P_F32(WS_VSSP)
#define lf P_F32(WS_LF)
#define halo P_F32(WS_HALO)
#define zb P_BF(WS_R1)
#define gb P_BF(WS_R1)
#define kb P_BF(WS_KB)
#define vb P_BF(WS_VB)
#define qb P_BF(WS_QB)
    if (tid < 64) ((LAS unsigned*)(L + MISC_OFF))[tid] = 0u;
    __syncthreads();
    const int lo = args.ph_lo, hi = args.ph_hi;
    const bool use_bar = (hi - lo) > 1;
    XcdBarrier bar; bar.bar = (unsigned*)(ws + WS_CTL) + 4096; bar.x = 0; bar.st = nullptr;
    if (use_bar) bar = xcd_barrier_post((unsigned*)(ws + WS_CTL) + 4096, MISC + 8);
#define IN(k) (lo <= (k) && (k) < hi)
#define SEAM(k) do { if (IN(k) && IN((k) + 1)) xcd_barrier(bar); } while (0)

    if (IN(0)) {
        LAS float* scr = (LAS float*)(L + wave * 16384);
        const int gw = vcu * NWAVES + wave, NGW = G * NWAVES;
        constexpr int I0 = 16 * 56, I1 = 16 * 32, I2 = 16 * 32, I3 = 16 * 176, I4 = 44 * 32, I5 = 16 * 88, I6 = 16 * 32, I7 = 16 * 176, I8 = 44 * 32;
        constexpr int NITEMS = I0 + I1 + I2 + I3 + I4 + I5 + I6 + I7 + I8;
        for (int it = gw; it < NITEMS; it += NGW) {
            int r = it;
            if (r < I0) { const int nb = r % 56, kb_ = r / 56; transpose_item(in[3], ZW, D, 64 * kb_, 32 * nb, ZW, in[2], (32 * nb >= 1536) ? C2 : 1.f, Win, 32 * nb, scr, lane); continue; } r -= I0;
            if (r < I1) { const int nb = r % 32, kb_ = r / 32; const bool lb = nb >= 16;
                transpose_item(lb ? in[21] : in[8], 512, D, 64 * kb_, 32 * (nb & 15), 512, lb ? in[20] : in[7], 1.f, Wmem, 32 * nb, scr, lane); continue; } r -= I1;
            if (r < I2) { const int nb = r % 32, kb_ = r / 32; transpose_item(in[9], D, D, 64 * kb_, 32 * nb, D, nullptr, 1.f, AWout, 32 * nb, scr, lane); continue; } r -= I2;
            if (r < I3 || (r >= I3 + I4 + I5 + I6 && r < I3 + I4 + I5 + I6 + I7)) { const bool lb = r >= I3; if (lb) r -= I3 + I4 + I5 + I6;
                const int nb = r % 176, kb_ = r / 176; const int n0 = 32 * nb, q = n0 >> 8, i = n0 & 255; const int src = (i < 128) ? (128 * q + i) : (DFF + 128 * q + (i - 128));
                transpose_item(lb ? in[24] : in[11], 5632, D, 64 * kb_, src, 5632, lb ? in[23] : in[10], 1.f, lb ? Bffi : Affi, n0, scr, lane); continue; } r -= I3;
            if (r < I4) { const int nb = r % 32, kb_ = r / 32; transpose_item(in[14], D, DFF, 64 * kb_, 32 * nb, D, nullptr, 1.f, Affo, 32 * nb, scr, lane); continue; } r -= I4;
            if (r < I5) { const int nb = r % 88, kb_ = r / 88; const int n0 = 32 * nb;
                if (n0 < 1536) transpose_item(in[16], 1548, D, 64 * kb_, n0, 1548, in[15], 1.f, Kvq, n0, scr, lane);
                else if (n0 < 2560) transpose_item(in[19], D, D, 64 * kb_, n0 - 1536, D, in[18], C2, Kvq, n0, scr, lane);
                else transpose_item(in[16], 1548, D, 64 * kb_, 1536 + (n0 - 2560), (n0 == 2560) ? 1548 : 0, in[15], 1.f, Kvq, n0, scr, lane);
                continue; } r -= I5;
            if (r < I6) { const int nb = r % 32, kb_ = r / 32; transpose_item(in[22], D, D, 64 * kb_, 32 * nb, D, nullptr, 1.f, BWout, 32 * nb, scr, lane); continue; } r -= I6;
            r -= I7;
            { const int nb = r % 32, kb_ = r / 32; transpose_item(in[27], D, DFF, 64 * kb_, 32 * nb, D, nullptr, 1.f, Bffo, 32 * nb, scr, lane); }
        }
        for (int m = gw; m < M; m += NGW) { const float s = row_to_bf16(in[0] + (size_t)m * D, xb + (size_t)m * D, lane); if (lane == 0) *(f32x4*)(ss4 + (size_t)m * 4) = (f32x4){s, 0.f, 0.f, 0.f}; }
        for (int m = gw; m < MROWS; m += NGW) { const float s = row_to_bf16(in[1] + (size_t)m * D, memb + (size_t)m * D, lane); if (lane == 0) *(f32x4*)(memss + (size_t)m * 4) = (f32x4){s, 0.f, 0.f, 0.f}; }
    }
    SEAM(0);
    if (IN(1)) {
        pg8::Sched S; S.init(M, ZW, D, G, bx, xb, Win); S.extra(MROWS, 1024, memb, Wmem);
        pg8::EpiIn E{zb, memkv, qmem, ss4, memss, vssp};
        pg8::gemm_phase<pg8::EpiIn, true, false>(L, S, E);
    }
    SEAM(1);
    if (IN(2)) {
        for (int uidx = vcu; uidx < 512; uidx += G) gmlp_unit(uidx >> 6, (uidx >> 2) & 15, uidx & 3, zb, vssp, in[5], in[6], in[4], mix, (char*)lds);
        for (int uidx = vcu; uidx < 256; uidx += G) { const int b = uidx >> 5, h = (uidx >> 3) & 3, qt = uidx & 7;
            const size_t row0 = (size_t)b * SEQ + qt * 256;
            attn_body::attn_unit<false, 8, MEMW, 1024, 1024, D>((const attn_body::bf16*)qmem + row0 * MEMW + 64 * h, (const attn_body::bf16*)memkv + (size_t)b * NMEM * 1024 + 64 * h,
                                           (const attn_body::bf16*)memkv + (size_t)b * NMEM * 1024 + 256 + 64 * h, (attn_body::bf16*)mix + row0 * D + TOK + 64 * h, 4, (char*)lds); }
    }
    SEAM(2);
    if (IN(3)) {
        pg8::Sched S; S.init(M, D, D, G, bx, mix, AWout);
        pg8::EpiRes E{in[0], xf, xb, ss4};
        pg8::gemm_phase<pg8::EpiRes, false, false>(L, S, E);
    }
    SEAM(3);
    if (IN(4)) {
        pg8::Sched S; S.init(M, 2 * DFF, D, G, bx, xb, Affi);
        pg8::EpiFfn E{gb, halo, ss4, in[12], in[13]};
        pg8::gemm_phase<pg8::EpiFfn, true, true>(L, S, E);
    }
    SEAM(4);
    if (IN(5)) fixup_phase(vcu, G, gb, halo, in[12], in[13]);
    SEAM(5);
    if (IN(6)) {
        pg8::Sched S; S.init(M, D, DFF, G, bx, gb, Affo);
        pg8::EpiRes E{xf, xf, xb, ss4};
        pg8::gemm_phase<pg8::EpiRes, false, false>(L, S, E);
    }
    SEAM(6);
    if (IN(7)) {
        pg8::Sched S; S.init(M, 2816, D, G, bx, xb, Kvq);
        pg8::EpiKvq E{kb, vb, qb, qmem, lf, ss4, in[17]};
        pg8::gemm_phase<pg8::EpiKvq, true, false>(L, S, E);
    }
    SEAM(7);
    if (IN(8)) {
        for (int v = vcu; v < 256; v += G) {
            const int grp = v >> 3, k8 = v & 7;
            const unsigned tbe = k8 == 0 ? 0x000c1cu : k8 == 1 ? 0x040d1du : k8 == 2 ? 0x05081eu : k8 == 3 ? 0x011018u : k8 == 4 ? 0x021419u : k8 == 5 ? 0x06111au : k8 == 6 ? 0x091215u : 0x0a0e16u;
#pragma unroll 1
            for (int i = 0; i < 3; ++i) {
                const unsigned e = (tbe >> (8 * i)) & 0xffu; const int qb_ = (int)(e >> 2), cp = (int)(e & 3u);
                const int bh = grp * 3 + cp, b = bh / NFOX, h = bh % NFOX;
                const int NT = 4 * qb_ + 4; const size_t rowb = (size_t)b * SEQ, row0 = rowb + qb_ * 256;
                attn_body::bias_scan(lf + ((size_t)b * NFOX + h) * SEQ, NT * 64, (char*)lds);
                attn_body::attn_unit<true, 8, KVW, KVW, KVW, D>((const attn_body::bf16*)qb + row0 * KVW + 64 * h, (const attn_body::bf16*)kb + rowb * KVW + 64 * h,
                                              (const attn_body::bf16*)vb + rowb * KVW + 64 * h, (attn_body::bf16*)mix + row0 * D + 64 * h, NT, (char*)lds);
            }
        }
        for (int uidx = vcu; uidx < 256; uidx += G) { const int b = uidx >> 5, h = (uidx >> 3) & 3, qt = uidx & 7;
            const size_t row0 = (size_t)b * SEQ + qt * 256;
            attn_body::attn_unit<false, 8, MEMW, 1024, 1024, D>((const attn_body::bf16*)qmem + row0 * MEMW + 64 * h, (const attn_body::bf16*)memkv + (size_t)b * NMEM * 1024 + 512 + 64 * h,
                                           (const attn_body::bf16*)memkv + (size_t)b * NMEM * 1024 + 768 + 64 * h, (attn_body::bf16*)mix + row0 * D + TOK + 64 * h, 4, (char*)lds); }
    }
    SEAM(8);
    if (IN(9)) {
        pg8::Sched S; S.init(M, D, D, G, bx, mix, BWout);
        pg8::EpiRes E{xf, xf, xb, ss4};
        pg8::gemm_phase<pg8::EpiRes, false, false>(L, S, E);
    }
    SEAM(9);
    if (IN(10)) {
        pg8::Sched S; S.init(M, 2 * DFF, D, G, bx, xb, Bffi);
        pg8::EpiFfn E{gb, halo, ss4, in[25], in[26]};
        pg8::gemm_phase<pg8::EpiFfn, true, true>(L, S, E);
    }
    SEAM(10);
    if (IN(11)) fixup_phase(vcu, G, gb, halo, in[25], in[26]);
    SEAM(11);
    if (IN(12)) {
        pg8::Sched S; S.init(M, D, DFF, G, bx, gb, Bffo);
        pg8::EpiRes E{xf, xf, xb, ss4};
        pg8::gemm_phase<pg8::EpiRes, false, false>(L, S, E);
    }
    SEAM(12);
    if (IN(13)) final_phase(vcu, G, wave, lane, xf, ss4, in[28]);
#undef IN
#undef SEAM
#undef in
#undef xf
#undef Win
#undef Wmem
#undef AWout
#undef Affi
#undef Affo
#undef Kvq
#undef BWout
#undef Bffi
#undef Bffo
#undef xb
#undef mix
#undef memb
#undef memkv
#undef qmem
#undef ss4
#undef memss
#undef vssp
#undef lf
#undef halo
#undef zb
#undef gb
#undef kb
#undef vb
#undef qb
}

#ifndef MK_N_LAUNCHES
#define MK_N_LAUNCHES 1
#endif
static int mk_grid() {
    static int grid = 0;
    if (grid == 0) {
        int dev = 0, cus = 0, per_cu = 0;
        if (hipGetDevice(&dev) != hipSuccess || hipDeviceGetAttribute(&cus, hipDeviceAttributeMultiprocessorCount, dev) != hipSuccess) { fprintf(stderr, "kernel_launch: device query failed\n"); grid = -1; return grid; }
        if (hipFuncSetAttribute((const void*)mk_fwd, hipFuncAttributeMaxDynamicSharedMemorySize, LDS_BYTES) != hipSuccess) { fprintf(stderr, "kernel_launch: hipFuncSetAttribute failed\n"); grid = -1; return grid; }
        if (hipOccupancyMaxActiveBlocksPerMultiprocessor(&per_cu, (const void*)mk_fwd, NTHR, LDS_BYTES) != hipSuccess || per_cu < 1) { fprintf(stderr, "kernel_launch: occupancy query reports %d blocks per CU\n", per_cu); grid = -1; return grid; }
        (void)hipGetLastError();
        grid = cus;
    }
    return grid;
}
static void mk_launch(void* const* d_in, void* d_out, void* d_ws, hipStream_t stream, int nlaunch) {
    const int grid = mk_grid(); if (grid <= 0) return;
    (void)hipMemsetAsync((char*)d_ws + WS_CTL, 0, CTL_ZERO_BYTES, stream);
    Args a{};
    for (int i = 0; i < 29; ++i) a.in[i] = (const float*)d_in[i];
    a.out = (float*)d_out; a.ws = (unsigned char*)d_ws;
    if (nlaunch == 1) { a.ph_lo = 0; a.ph_hi = N_PHASES; hipLaunchKernelGGL(mk_fwd, dim3(grid), dim3(NTHR), LDS_BYTES, stream, a); }
    else for (int p = 0; p < N_PHASES; ++p) { a.ph_lo = p; a.ph_hi = p + 1; hipLaunchKernelGGL(mk_fwd, dim3(grid), dim3(NTHR), LDS_BYTES, stream, a); }
}

extern "C" void kernel_launch(void* const* d_in, const int* in_sizes, int n_in, void* d_out, int out_size, void* d_ws, size_t ws_size, hipStream_t stream) {
    if (n_in != 29 || out_size != M * D || ws_size < WS_END) { fprintf(stderr, "kernel_launch: unexpected sizes\n"); return; }
    mk_launch(d_in, d_out, d_ws, stream, MK_N_LAUNCHES);
}
```

```cpp
#define MK_N_LAUNCHES 1
#include <hip/hip_runtime.h>
#include <hip/hip_bf16.h>
#include <cstdio>
#include <cstdint>
#include <cmath>

#define LAS __attribute__((address_space(3)))
#define GAS __attribute__((address_space(1)))
typedef unsigned short bf16_t;
typedef short bf16x8 __attribute__((ext_vector_type(8)));
typedef float f32x4 __attribute__((ext_vector_type(4)));
typedef float f32x2 __attribute__((ext_vector_type(2)));
typedef float f32x16 __attribute__((ext_vector_type(16)));
typedef unsigned u32x4 __attribute__((ext_vector_type(4)));
typedef unsigned u32x2 __attribute__((ext_vector_type(2)));
typedef short s16x4 __attribute__((ext_vector_type(4)));

constexpr int NB = 8, SEQ = 2048, D = 1024, M = NB * SEQ, NMEM = 256, MROWS = NB * NMEM;
constexpr int TOK = 768, MEMW = 256, DFF = 2816, NFOX = 12, ZW = 1792, KVW = 768;
constexpr float EPS = 1e-6f;
constexpr float LOG2E = 1.4426950408889634f;
constexpr float C2 = 0.125f * LOG2E;
constexpr int NWAVES = 8, NTHR = 512;

constexpr size_t MiB = 1u << 20;
constexpr size_t WS_CTL = 0, CTL_ZERO_BYTES = 64 * 1024;
constexpr size_t WS_WIN = 1 * MiB;
constexpr size_t WS_WMEM = 5 * MiB;
constexpr size_t WS_AWOUT = 7 * MiB;
constexpr size_t WS_AFFI = 9 * MiB;
constexpr size_t WS_AFFO = 20 * MiB;
constexpr size_t WS_KVQ = 26 * MiB;
constexpr size_t WS_BWOUT = 32 * MiB;
constexpr size_t WS_BFFI = 34 * MiB;
constexpr size_t WS_BFFO = 45 * MiB;
constexpr size_t WS_XB = 51 * MiB;
constexpr size_t WS_MIX = 83 * MiB;
constexpr size_t WS_MEMB = 115 * MiB;
constexpr size_t WS_MEMKV = 119 * MiB;
constexpr size_t WS_SS4 = 123 * MiB;
constexpr size_t WS_MEMSS = 123 * MiB + 256 * 1024;
constexpr size_t WS_VSSP = 123 * MiB + 512 * 1024;
constexpr size_t WS_LF = 124 * MiB + 512 * 1024;
constexpr size_t WS_HALO = 126 * MiB;
constexpr size_t WS_R1 = 137 * MiB;
constexpr size_t WS_KB = WS_R1, WS_VB = WS_R1 + 24 * MiB, WS_QB = WS_R1 + 48 * MiB;
constexpr size_t WS_QMEM = 225 * MiB;
constexpr size_t WS_END = 233 * MiB;

constexpr int RING_BYTES = 131072;
constexpr int MISC_OFF = RING_BYTES;
constexpr int LDS_BYTES = 147456;

#define RLX_AGENT __ATOMIC_RELAXED, __HIP_MEMORY_SCOPE_AGENT
__device__ __forceinline__ unsigned f2bf(float f) { unsigned u = __builtin_bit_cast(unsigned, f); return (u + 0x7fffu + ((u >> 16) & 1u)) >> 16; }
__device__ __forceinline__ unsigned pk2(float lo, float hi) {
    typedef __bf16 bf2 __attribute__((ext_vector_type(2)));
    f32x2 v = {lo, hi}; bf2 b = __builtin_convertvector(v, bf2); return __builtin_bit_cast(unsigned, b); }
__device__ __forceinline__ float bf_lo(unsigned u) { return __builtin_bit_cast(float, u << 16); }
__device__ __forceinline__ float bf_hi(unsigned u) { return __builtin_bit_cast(float, u & 0xffff0000u); }
__device__ __forceinline__ float wave_sum(float v) {
#pragma unroll
    for (int o = 1; o < 64; o <<= 1) v += __shfl_xor(v, o);
    return v;
}
__device__ __forceinline__ float gelu_tanh(float x) {
    const float u = x * (0.7978845608028654f + 0.035677408136300125f * x * x);
    return x * __builtin_amdgcn_rcpf(1.0f + __builtin_amdgcn_exp2f(-2.0f * LOG2E * u));
}
__device__ __forceinline__ float silu_f(float x) { return x * __builtin_amdgcn_rcpf(1.0f + __builtin_amdgcn_exp2f(-LOG2E * x)); }
__device__ __forceinline__ float log_sigmoid_f(float x) { return x >= 0.f ? -log1pf(__expf(-x)) : x - log1pf(__expf(x)); }

#define XB_TMO      128
#define XB_XCNT(j)  (256  + 64 * (j))
#define XB_XSUB(j)  (1280 + 64 * (j))
#define XB_XGEN(j)  (2304 + 64 * (j))
#define XB_TOP      3328
#define XB_TOPGEN   3392
#define XCD_BAR_WORDS 3456
#define XB_SPIN_CAP (1u << 18)
__device__ __forceinline__ unsigned xb_ld(unsigned* p)              { return __hip_atomic_load(p, __ATOMIC_RELAXED, __HIP_MEMORY_SCOPE_AGENT); }
__device__ __forceinline__ unsigned xb_add(unsigned* p, unsigned v) { return __hip_atomic_fetch_add(p, v, __ATOMIC_RELAXED, __HIP_MEMORY_SCOPE_AGENT); }
__device__ __forceinline__ unsigned xb_xcc_id() { return (unsigned)__builtin_amdgcn_s_getreg((3 << 11) | 20) & 0xFu; }
#define XB_SPIN(cond, bar) do { unsigned _sp = 0; while (cond) { __builtin_amdgcn_s_sleep(1); \
    if ((++_sp & 255u) == 0u) { if (xb_ld(&(bar)[XB_TMO])) break; if (_sp > XB_SPIN_CAP) { atomicAdd(&(bar)[XB_TMO], 1u); break; } } } } while (0)
struct XcdBarrier { unsigned* bar; unsigned x; volatile LAS unsigned* st; };
__device__ __forceinline__ XcdBarrier xcd_barrier_post(unsigned* bar, volatile LAS unsigned* st) {
    XcdBarrier b; b.bar = bar; b.x = xb_xcc_id(); b.st = st;
    if (threadIdx.x == 0) (void)xb_add(&bar[XB_XCNT(b.x)], 1u);
    return b;
}
__device__ __forceinline__ void xcd_barrier_complete(unsigned* bar, unsigned x, unsigned& nloc, unsigned& nx) {
    const unsigned G = gridDim.x * gridDim.y * gridDim.z;
    unsigned sum, cnt, mine, sp = 0u;
    for (;;) {
        sum = 0u; cnt = 0u; mine = 0u;
#pragma unroll
        for (unsigned j = 0; j < 16; ++j) { const unsigned c = xb_ld(&bar[XB_XCNT(j)]); sum += c; cnt += (c > 0u) ? 1u : 0u; mine = (j == x) ? c : mine; }
        if (sum == G) break;
        __builtin_amdgcn_s_sleep(1);
        if ((++sp & 255u) == 0u) { if (xb_ld(&bar[XB_TMO])) break; if (sp > XB_SPIN_CAP) { atomicAdd(&bar[XB_TMO], 1u); break; } }
    }
    nloc = mine > 0u ? mine : 1u; nx = cnt > 0u ? cnt : 1u;
}
__device__ __forceinline__ void xcd_barrier(const XcdBarrier& b) {
    asm volatile("s_waitcnt vmcnt(0)" ::: "memory");
    __syncthreads();
    if (threadIdx.x == 0) {
        unsigned* bar = b.bar;
        __builtin_amdgcn_s_waitcnt(0);
        unsigned nloc = b.st[0], nx = b.st[1];
        if (nloc == 0u) { xcd_barrier_complete(bar, b.x, nloc, nx); b.st[0] = nloc; b.st[1] = nx; }
        const unsigned old = xb_add(&bar[XB_XSUB(b.x)], 1u);
        const unsigned gen = old / nloc;
        if (old + 1u == (gen + 1u) * nloc) {
            __builtin_amdgcn_fence(__ATOMIC_RELEASE, "agent");
            asm volatile("s_waitcnt vmcnt(0)" ::: "memory");
            const unsigned og = xb_add(&bar[XB_TOP], 1u);
            const unsigned tg = og / nx;
            if (og + 1u == (tg + 1u) * nx) xb_add(&bar[XB_TOPGEN], 1u);
            else XB_SPIN(xb_ld(&bar[XB_TOPGEN]) == tg, bar);
            __builtin_amdgcn_fence(__ATOMIC_ACQUIRE, "agent");
            xb_add(&bar[XB_XGEN(b.x)], 1u);
            asm volatile("s_waitcnt vmcnt(0)" ::: "memory");
        } else {
            XB_SPIN(xb_ld(&bar[XB_XGEN(b.x)]) == gen, bar);
            __builtin_amdgcn_fence(__ATOMIC_ACQUIRE, "agent");
            asm volatile("s_waitcnt vmcnt(0)" ::: "memory");
        }
    }
    __syncthreads();
}

namespace pg8 {
constexpr int BM = 256, BK = 64, HALF = 128, HTB = HALF * BK * 2, STAGE_BYTES = 8 * HTB, NXCD = 8, WGM = 8;
__host__ __device__ __forceinline__ int lds_byte(int r, int c) { const int st = (r >> 4) * 2 + (c >> 5), rr = r & 15, cc = c & 31, ob = rr * 64 + cc * 2; return st * 1024 + (ob ^ (((ob >> 9) & 1) << 5)); }
__host__ __device__ __forceinline__ void stage_rc(int b, int& R, int& C) { const int st = b / 1024, sb = b % 1024, swz = sb ^ (((sb >> 9) & 1) << 5); R = (st >> 1) * 16 + swz / 64; C = (st & 1) * 32 + (swz % 64) / 2; }
__host__ __device__ __forceinline__ int perm32(int rho) { const int n = rho >> 4, i = rho & 15; return 8 * (i >> 2) + 4 * n + (i & 3); }

struct Unit { int pm, pn, kind; };
struct Sched {
    int nM, nN, nwg, G, c, K; const bf16_t* A; const bf16_t* Bt;
    int nwg2, nM2; const bf16_t* A2; const bf16_t* Bt2;
    __device__ __forceinline__ void init(int M_, int N_, int K_, int G_, int c_, const bf16_t* A_, const bf16_t* Bt_) { nM = M_ / BM; nN = N_ / BM; nwg = nM * nN; G = G_; c = c_; K = K_; A = A_; Bt = Bt_; nwg2 = 0; nM2 = 1; A2 = A_; Bt2 = Bt_; }
    __device__ __forceinline__ void extra(int M2, int N2, const bf16_t* A2_, const bf16_t* Bt2_) { nM2 = M2 / BM; nwg2 = nM2 * (N2 / BM); A2 = A2_; Bt2 = Bt2_; }
    __device__ __forceinline__ bool next(int i, Unit& u) const {
        const long L = (long)i * G + c;
        if (L >= nwg) { const long e = L - nwg; if (e >= nwg2) return false; u.pm = (int)(e % nM2); u.pn = (int)(e / nM2); u.kind = 1; return true; }
        int wgid = (int)L; { const int q = nwg / NXCD, r = nwg % NXCD, xcd = wgid % NXCD, off = wgid / NXCD; wgid = (xcd < r ? xcd * (q + 1) : r * (q + 1) + (xcd - r) * q) + off; }
        const int nig = WGM * nN, gid = wgid / nig, fm = gid * WGM, gsz = (nM - fm) < WGM ? (nM - fm) : WGM;
        u.pm = fm + ((wgid % nig) % gsz); u.pn = (wgid % nig) / gsz; u.kind = 0; return true;
    }
    __device__ __forceinline__ const char* a_ptr(const Unit& u) const { return (const char*)(u.kind ? A2 : A) + (size_t)u.pm * BM * K * 2; }
    __device__ __forceinline__ const char* b_ptr(const Unit& u) const { return (const char*)(u.kind ? Bt2 : Bt) + (size_t)u.pn * BM * K * 2; }
};

template <class Epi, bool ALIGN_EPI, bool A_PERM>
__device__ __forceinline__ void gemm_phase(LAS unsigned char* lds, const Sched& S, const Epi& E) {
    int tid = threadIdx.x; asm volatile("" : "+v"(tid));
    const int wid = __builtin_amdgcn_readfirstlane(tid >> 6), lane = tid & 63, wr = wid >> 2, wc = wid & 3, fr = lane & 15, fq = lane >> 4;
    const int K = S.K, nt = K / BK;
    unsigned voffA[2], voffB[2];
#pragma unroll
    for (int i = 0; i < 2; ++i) { int R, C; stage_rc(tid * 16 + i * 8192, R, C); const int Rb = (R & ~31) + perm32(R & 31);
        const int Ra = A_PERM ? (128 * (R >> 6) + 8 * (R & 15) + ((R >> 4) & 3)) : R;
        voffA[i] = (unsigned)(Ra * K + C) * 2u; voffB[i] = (unsigned)(Rb * K + C) * 2u; }
    const size_t kstep = (size_t)(BK * 2);
    const size_t hstepB = (size_t)HALF * K * 2;
    const size_t hstepA = A_PERM ? (size_t)4 * K * 2 : (size_t)HALF * K * 2;
    const unsigned ldsw = (unsigned)wid * 1024u;
    const int aoff = lds_byte(wr * 64 + fr, fq * 8), boff = lds_byte(wc * 32 + fr, fq * 8);
#define PG8_SA(b, h) (((b) * 2 + (h)) * HTB)
#define PG8_SB(b, h) ((4 + (b) * 2 + (h)) * HTB)
#define PG8_STAGE(bufoff, gbase, voff) do { _Pragma("unroll") for (int _i = 0; _i < 2; ++_i) \
        __builtin_amdgcn_global_load_lds((const unsigned*)((const char*)(gbase) + (voff)[_i]), (LAS unsigned*)(lds + (bufoff) + ldsw + _i * 8192), 16, 0, 0); } while (0)
#define PG8_LDA(dst, b, h) do { _Pragma("unroll") for (int m = 0; m < 4; ++m) _Pragma("unroll") for (int k = 0; k < 2; ++k) dst[m][k] = *(const LAS bf16x8*)(lds + PG8_SA(b, h) + aoff + m * 2048 + k * 1024); } while (0)
#define PG8_LDB(dst, b, h) do { _Pragma("unroll") for (int n = 0; n < 2; ++n) _Pragma("unroll") for (int k = 0; k < 2; ++k) dst[n][k] = *(const LAS bf16x8*)(lds + PG8_SB(b, h) + boff + n * 2048 + k * 1024); } while (0)
#define PG8_MMA(ai, bj, At, Bt) do { __builtin_amdgcn_s_setprio(1); _Pragma("unroll") for (int m = 0; m < 4; ++m) _Pragma("unroll") for (int n = 0; n < 2; ++n) _Pragma("unroll") for (int k = 0; k < 2; ++k) \
        acc[ai][bj][m][n] = __builtin_amdgcn_mfma_f32_16x16x32_bf16(Bt[n][k], At[m][k], acc[ai][bj][m][n], 0, 0, 0); __builtin_amdgcn_s_setprio(0); } while (0)
#define PG8_WAIT_V(n) asm volatile("s_waitcnt vmcnt(" #n ")" ::: "memory")
#define PG8_WAIT_L(n) asm volatile("s_waitcnt lgkmcnt(" #n ")" ::: "memory")
#define PG8_BAR __builtin_amdgcn_s_barrier()
#define PG8_SCHED __builtin_amdgcn_sched_barrier(0)
    Unit cur, nxt; int ui = 0;
    if (!S.next(0, cur)) return;
    f32x4 acc[2][2][4][2];
#pragma unroll
    for (int a = 0; a < 2; ++a)
#pragma unroll
        for (int b = 0; b < 2; ++b)
#pragma unroll
            for (int m = 0; m < 4; ++m)
#pragma unroll
                for (int n = 0; n < 2; ++n) acc[a][b][m][n] = (f32x4){0.f, 0.f, 0.f, 0.f};
    bf16x8 At[4][2], B0[2][2], B1[2][2];
    const char* cA = S.a_ptr(cur); const char* cB = S.b_ptr(cur);
    PG8_STAGE(PG8_SB(0, 0), cB, voffB); PG8_STAGE(PG8_SB(0, 1), cB + hstepB, voffB); PG8_STAGE(PG8_SA(0, 0), cA, voffA); PG8_STAGE(PG8_SA(0, 1), cA + hstepA, voffA);
    if (wr == 1) PG8_BAR;
    PG8_WAIT_V(2); PG8_BAR;
    PG8_STAGE(PG8_SB(1, 0), cB + kstep, voffB); PG8_STAGE(PG8_SA(1, 0), cA + kstep, voffA); PG8_STAGE(PG8_SB(1, 1), cB + hstepB + kstep, voffB);
    PG8_WAIT_V(6); PG8_BAR;
    for (;;) {
        const bool has_next = S.next(ui + 1, nxt);
        const char* nA = has_next ? S.a_ptr(nxt) : cA; const char* nB = has_next ? S.b_ptr(nxt) : cB;
        for (int t = 0; t < nt; t += 2) {
            const bool last = (t == nt - 2);
            const char* a1 = cA + (size_t)(t + 1) * kstep;
            const char* a2 = last ? nA : cA + (size_t)(t + 2) * kstep; const char* b2 = last ? nB : cB + (size_t)(t + 2) * kstep;
            const char* a3 = a2 + kstep; const char* b3 = b2 + kstep;
            PG8_LDB(B0, 0, 0); PG8_LDB(B1, 0, 1); PG8_SCHED; PG8_LDA(At, 0, 0); PG8_STAGE(PG8_SA(1, 1), a1 + hstepA, voffA);
            PG8_WAIT_V(8); PG8_WAIT_L(0); PG8_BAR; PG8_MMA(0, 0, At, B0); PG8_MMA(0, 1, At, B1); PG8_BAR; PG8_SCHED;
            PG8_LDA(At, 0, 1); PG8_STAGE(PG8_SB(0, 0), b2, voffB); PG8_STAGE(PG8_SB(0, 1), b2 + hstepB, voffB); PG8_STAGE(PG8_SA(0, 0), a2, voffA);
            PG8_WAIT_V(8); PG8_WAIT_L(0); PG8_BAR; PG8_MMA(1, 0, At, B0); PG8_MMA(1, 1, At, B1); PG8_BAR; PG8_SCHED;
            PG8_LDB(B0, 1, 0); PG8_LDB(B1, 1, 1); PG8_SCHED; PG8_LDA(At, 1, 0); PG8_STAGE(PG8_SA(0, 1), a2 + hstepA, voffA);
            PG8_WAIT_V(8); PG8_WAIT_L(0); PG8_BAR; PG8_MMA(0, 0, At, B0); PG8_MMA(0, 1, At, B1); PG8_BAR; PG8_SCHED;
            PG8_LDA(At, 1, 1); PG8_STAGE(PG8_SB(1, 0), b3, voffB); PG8_STAGE(PG8_SB(1, 1), b3 + hstepB, voffB); PG8_STAGE(PG8_SA(1, 0), a3, voffA);
            PG8_WAIT_V(8); PG8_WAIT_L(0); PG8_BAR; PG8_MMA(1, 0, At, B0); PG8_MMA(1, 1, At, B1); PG8_BAR; PG8_SCHED;
        }
        if constexpr (ALIGN_EPI) { if (wr == 0) PG8_BAR; }
        if constexpr (!Epi::AFTER_DRAIN) { E(acc, cur, wr, wc, fr, fq); }
        if (!has_next) break;
#pragma unroll
        for (int a = 0; a < 2; ++a)
#pragma unroll
            for (int b = 0; b < 2; ++b)
#pragma unroll
                for (int m = 0; m < 4; ++m)
#pragma unroll
                    for (int n = 0; n < 2; ++n) acc[a][b][m][n] = (f32x4){0.f, 0.f, 0.f, 0.f};
        cur = nxt; cA = nA; cB = nB; ++ui;
        if constexpr (ALIGN_EPI) { if (wr == 1) PG8_BAR; }
    }
    PG8_WAIT_V(0);
    if constexpr (!ALIGN_EPI) { if (wr == 0) PG8_BAR; }
    PG8_BAR;
    if constexpr (Epi::AFTER_DRAIN) { E.fused(acc, cur, wr, wc, fr, fq, lds, wid, lane); }
#undef PG8_SA
#undef PG8_SB
#undef PG8_STAGE
#undef PG8_LDA
#undef PG8_LDB
#undef PG8_MMA
#undef PG8_WAIT_V
#undef PG8_WAIT_L
#undef PG8_BAR
#undef PG8_SCHED
}
}

namespace pg8 {
__device__ __forceinline__ float rstd_of(const float* ss4, int row) { const f32x4 s = *(const f32x4*)(ss4 + (size_t)row * 4); return rsqrtf(((s[0] + s[1]) + (s[2] + s[3])) * (1.0f / D) + EPS); }

struct EpiIn {
    static constexpr bool AFTER_DRAIN = false;
    bf16_t* z; bf16_t* memkv; bf16_t* qmem; const float* ss4; const float* memss; float* vssp;
    __device__ __forceinline__ void operator()(const f32x4 (&acc)[2][2][4][2], const Unit& u, int wr, int wc, int fr, int fq) const {
        const bool main = (u.kind == 0), act = main && (u.pn < 6), vt = main && (u.pn >= 3) && (u.pn < 6);
        bf16_t* obase = main ? z : memkv; int ldc = main ? ZW : 1024;
        int col0 = u.pn * BM + wc * 32 + 8 * fq;
        if (main && u.pn == 6) { obase = qmem; ldc = MEMW; col0 -= 6 * BM; }
        const float* ssb = main ? ss4 : memss;
        float rsv[8];
#pragma unroll
        for (int j = 0; j < 8; ++j) rsv[j] = rstd_of(ssb, u.pm * BM + (j >> 2) * HALF + wr * 64 + (j & 3) * 16 + fr);
#pragma unroll
        for (int ai = 0; ai < 2; ++ai)
#pragma unroll
            for (int m = 0; m < 4; ++m) {
                const int row = u.pm * BM + ai * HALF + wr * 64 + m * 16 + fr;
                const float rs = rsv[ai * 4 + m];
                float sq = 0.f;
#pragma unroll
                for (int bj = 0; bj < 2; ++bj) {
                    f32x4 v0 = acc[ai][bj][m][0] * rs, v1 = acc[ai][bj][m][1] * rs;
                    if (act) {
#pragma unroll
                        for (int e = 0; e < 4; ++e) { v0[e] = gelu_tanh(v0[e]); v1[e] = gelu_tanh(v1[e]); }
                    }
                    sq += (v0[0] * v0[0] + v0[1] * v0[1]) + (v0[2] * v0[2] + v0[3] * v0[3]) + (v1[0] * v1[0] + v1[1] * v1[1]) + (v1[2] * v1[2] + v1[3] * v1[3]);
                    u32x4 w; w.x = pk2(v0[0], v0[1]); w.y = pk2(v0[2], v0[3]); w.z = pk2(v1[0], v1[1]); w.w = pk2(v1[2], v1[3]);
                    *(u32x4*)(obase + (size_t)row * ldc + col0 + bj * HALF) = w;
                }
                if (vt) { sq += __shfl_xor(sq, 16); sq += __shfl_xor(sq, 32); if (fq == 0) vssp[(size_t)row * 12 + (u.pn - 3) * 4 + wc] = sq; }
            }
    }
};

struct EpiKvq {
    static constexpr bool AFTER_DRAIN = false;
    bf16_t* kb; bf16_t* vb; bf16_t* qb; bf16_t* qmem; float* lf; const float* ss4; const float* b_f;
    __device__ __forceinline__ void operator()(const f32x4 (&acc)[2][2][4][2], const Unit& u, int wr, int wc, int fr, int fq) const {
        bf16_t* obase; int ldc, colt;
        if (u.pn < 3) { obase = kb; ldc = KVW; colt = u.pn * BM; } else if (u.pn < 6) { obase = vb; ldc = KVW; colt = (u.pn - 3) * BM; } else if (u.pn < 9) { obase = qb; ldc = KVW; colt = (u.pn - 6) * BM; } else { obase = qmem; ldc = MEMW; colt = 0; }
        const int col0 = colt + wc * 32 + 8 * fq;
        const bool ftile = (u.pn == 10);
        float rsv[8];
#pragma unroll
        for (int j = 0; j < 8; ++j) rsv[j] = rstd_of(ss4, u.pm * BM + (j >> 2) * HALF + wr * 64 + (j & 3) * 16 + fr);
#pragma unroll
        for (int ai = 0; ai < 2; ++ai)
#pragma unroll
            for (int m = 0; m < 4; ++m) {
                const int row = u.pm * BM + ai * HALF + wr * 64 + m * 16 + fr;
                const float rs = rsv[ai * 4 + m];
                if (!ftile) {
#pragma unroll
                    for (int bj = 0; bj < 2; ++bj) {
                        const f32x4 v0 = acc[ai][bj][m][0] * rs, v1 = acc[ai][bj][m][1] * rs;
                        u32x4 w; w.x = pk2(v0[0], v0[1]); w.y = pk2(v0[2], v0[3]); w.z = pk2(v1[0], v1[1]); w.w = pk2(v1[2], v1[3]);
                        *(u32x4*)(obase + (size_t)row * ldc + col0 + bj * HALF) = w;
                    }
                } else if (wc == 0 && fq < 2) {
                    const int b = row / SEQ, t = row % SEQ;
#pragma unroll
                    for (int n = 0; n < 2; ++n)
#pragma unroll
                        for (int e = 0; e < 4; ++e) { const int h = 8 * fq + 4 * n + e; if (h < NFOX) lf[((size_t)b * NFOX + h) * SEQ + t] = log_sigmoid_f(acc[ai][0][m][n][e] * rs + b_f[h]); }
                }
            }
    }
};

template <bool R_F32, bool OUT_F32>
struct EpiRes {
    static constexpr bool AFTER_DRAIN = true;
    const float* R; float* xf; bf16_t* xb; float* ss4;
    __device__ __forceinline__ void fused(f32x4 (&acc)[2][2][4][2], const Unit& u, int wr, int wc, int fr, int fq, LAS unsigned char* lds, int wid, int lane) const {
        LAS float* P = (LAS float*)lds;
        const int col0 = u.pn * BM + wc * 32 + 8 * fq;
        if constexpr (!R_F32) {
            u32x4 rb[2][4][2];
#pragma unroll
            for (int ai = 0; ai < 2; ++ai)
#pragma unroll
                for (int m = 0; m < 4; ++m)
#pragma unroll
                    for (int bj = 0; bj < 2; ++bj) rb[ai][m][bj] = *(const u32x4*)(xb + (size_t)(u.pm * BM + ai * HALF + wr * 64 + m * 16 + fr) * D + col0 + bj * HALF);
#pragma unroll
            for (int ai = 0; ai < 2; ++ai)
#pragma unroll
                for (int m = 0; m < 4; ++m)
#pragma unroll
                    for (int bj = 0; bj < 2; ++bj) { const u32x4 w = rb[ai][m][bj];
                        acc[ai][bj][m][0] += (f32x4){bf_lo(w.x), bf_hi(w.x), bf_lo(w.y), bf_hi(w.y)}; acc[ai][bj][m][1] += (f32x4){bf_lo(w.z), bf_hi(w.z), bf_lo(w.w), bf_hi(w.w)}; }
        } else {
#pragma unroll
            for (int ai = 0; ai < 2; ++ai) {
                f32x4 rf[4][2][2];
#pragma unroll
                for (int m = 0; m < 4; ++m)
#pragma unroll
                    for (int bj = 0; bj < 2; ++bj) { const float* rp = R + (size_t)(u.pm * BM + ai * HALF + wr * 64 + m * 16 + fr) * D + col0 + bj * HALF; rf[m][bj][0] = *(const f32x4*)rp; rf[m][bj][1] = *(const f32x4*)(rp + 4); }
#pragma unroll
                for (int m = 0; m < 4; ++m)
#pragma unroll
                    for (int bj = 0; bj < 2; ++bj) { acc[ai][bj][m][0] += rf[m][bj][0]; acc[ai][bj][m][1] += rf[m][bj][1]; }
            }
        }
#pragma unroll
        for (int ai = 0; ai < 2; ++ai)
#pragma unroll
            for (int m = 0; m < 4; ++m) {
                const int rl = ai * HALF + wr * 64 + m * 16 + fr; const size_t off = (size_t)(u.pm * BM + rl) * D + col0;
                float sq = 0.f;
#pragma unroll
                for (int bj = 0; bj < 2; ++bj) {
                    const f32x4 v0 = acc[ai][bj][m][0], v1 = acc[ai][bj][m][1];
                    if constexpr (OUT_F32) { *(f32x4*)(xf + off + bj * HALF) = v0; *(f32x4*)(xf + off + bj * HALF + 4) = v1; }
                    else { u32x4 w; w.x = pk2(v0[0], v0[1]); w.y = pk2(v0[2], v0[3]); w.z = pk2(v1[0], v1[1]); w.w = pk2(v1[2], v1[3]); *(u32x4*)(xb + off + bj * HALF) = w; }
                    sq += (v0[0] * v0[0] + v0[1] * v0[1]) + (v0[2] * v0[2] + v0[3] * v0[3]) + (v1[0] * v1[0] + v1[1] * v1[1]) + (v1[2] * v1[2] + v1[3] * v1[3]);
                }
                sq += __shfl_xor(sq, 16); sq += __shfl_xor(sq, 32);
                if (fq == 0) P[rl * 4 + wc] = sq;
            }
        __syncthreads();
        if (threadIdx.x < 256) { const int rl = threadIdx.x; const f32x4 p = *(const LAS f32x4*)(P + rl * 4); ss4[(size_t)(u.pm * BM + rl) * 4 + u.pn] = (p[0] + p[1]) + (p[2] + p[3]); }
        __syncthreads();
    }
};

__device__ __forceinline__ float dpp_shr1_f(float x) {
    int xi = __builtin_bit_cast(int, x);
    asm volatile("" : "+v"(xi));
    return __builtin_bit_cast(float, __builtin_amdgcn_update_dpp(0, xi, 0x111, 0xf, 0xf, true));
}
__device__ __forceinline__ f32x4 dpp_shr1(f32x4 v) { f32x4 r; r[0] = dpp_shr1_f(v[0]); r[1] = dpp_shr1_f(v[1]); r[2] = dpp_shr1_f(v[2]); r[3] = dpp_shr1_f(v[3]); return r; }
struct EpiFfn {
    static constexpr bool AFTER_DRAIN = false;
    bf16_t* g; float* halo; const float* ss4; const float* cw; const float* cb;
    __device__ __forceinline__ void operator()(f32x4 (&acc)[2][2][4][2], const Unit& u, int wr, int wc, int fr, int fq) const {
        const int T0 = u.pm * BM + wr * 128 + fr * 8;
        float rsv[8];
#pragma unroll
        for (int j = 0; j < 8; ++j) rsv[j] = rstd_of(ss4, T0 + j);
#pragma unroll
        for (int j = 0; j < 8; ++j) { const float r = rsv[j];
#pragma unroll
            for (int bj = 0; bj < 2; ++bj)
#pragma unroll
                for (int n = 0; n < 2; ++n) acc[j >> 2][bj][j & 3][n] *= r; }
        const int jc0 = u.pn * 128 + wc * 32 + 8 * fq;
        const int run = u.pm * 2 + wr;
        float* hrun = halo + (size_t)run * 4 * 5632 + u.pn * BM + wc * 32 + 8 * fq;
        unsigned pk[2][8][2];
#pragma unroll
        for (int n = 0; n < 2; ++n) {
            if (fr == 0) { *(f32x4*)(hrun + 4 * n) = acc[0][0][0][n]; *(f32x4*)(hrun + 5632 + 4 * n) = acc[0][0][1][n]; *(f32x4*)(hrun + HALF + 4 * n) = acc[0][1][0][n]; *(f32x4*)(hrun + 5632 + HALF + 4 * n) = acc[0][1][1][n]; }
            if (fr == 15) { *(f32x4*)(hrun + 2 * 5632 + 4 * n) = acc[1][0][2][n]; *(f32x4*)(hrun + 3 * 5632 + 4 * n) = acc[1][0][3][n]; *(f32x4*)(hrun + 2 * 5632 + HALF + 4 * n) = acc[1][1][2][n]; *(f32x4*)(hrun + 3 * 5632 + HALF + 4 * n) = acc[1][1][3][n]; }
        }
#pragma unroll
        for (int n = 0; n < 2; ++n) {
            const int cg = jc0 + 4 * n, cu = DFF + cg;
#pragma unroll
            for (int bj = 0; bj < 2; ++bj) {
                const int cc = bj ? cu : cg;
                const f32x4 w0 = *(const f32x4*)(cw + cc), w1 = *(const f32x4*)(cw + 5632 + cc), w2 = *(const f32x4*)(cw + 2 * 5632 + cc), bb = *(const f32x4*)(cb + cc);
                const f32x4 p1 = dpp_shr1(acc[1][bj][3][n]), p2 = dpp_shr1(acc[1][bj][2][n]);
#pragma unroll
                for (int j = 7; j >= 0; --j) {
                    const f32x4 h1 = j >= 1 ? acc[(j >= 1 ? j - 1 : 0) >> 2][bj][(j >= 1 ? j - 1 : 0) & 3][n] : p1;
                    const f32x4 h2 = j >= 2 ? acc[(j >= 2 ? j - 2 : 0) >> 2][bj][(j >= 2 ? j - 2 : 0) & 3][n] : (j == 1 ? p1 : p2);
                    acc[j >> 2][bj][j & 3][n] = bb + w2 * acc[j >> 2][bj][j & 3][n] + w1 * h1 + w0 * h2;
                }
            }
#pragma unroll
            for (int j = 0; j < 8; ++j) {
                const f32x4 cgv = acc[j >> 2][0][j & 3][n], cuv = acc[j >> 2][1][j & 3][n];
                f32x4 o;
#pragma unroll
                for (int e = 0; e < 4; ++e) o[e] = silu_f(cgv[e]) * cuv[e];
                pk[n][j][0] = pk2(o[0], o[1]); pk[n][j][1] = pk2(o[2], o[3]);
            }
        }
#pragma unroll
        for (int j = 0; j < 8; ++j) {
            u32x4 w; w.x = pk[0][j][0]; w.y = pk[0][j][1]; w.z = pk[1][j][0]; w.w = pk[1][j][1];
            *(u32x4*)(g + (size_t)(T0 + j) * DFF + jc0) = w;
        }
    }
};
}

__device__ __forceinline__ void fixup_panel(int pm, bf16_t* g, const float* halo, const float* cw, const float* cb) {
    for (int it = threadIdx.x; it < 4 * 704; it += NTHR) {
        const int rj = it / 704, grp = it % 704, run = 2 * pm + (rj >> 1), j = rj & 1;
        if ((run & 15) == 0) continue;
        const int col = grp * 4, q = col >> 7, i = col & 127, ng = q * 256 + i;
        const float* hc = halo + (size_t)run * 4 * 5632; const float* hp = halo + (size_t)(run - 1) * 4 * 5632;
        f32x4 r[2];
#pragma unroll
        for (int p = 0; p < 2; ++p) {
            const int nn = ng + 128 * p, cc = col + DFF * p;
            const f32x4 h0 = *(const f32x4*)(hc + nn), h1 = *(const f32x4*)(hc + 5632 + nn), p2 = *(const f32x4*)(hp + 2 * 5632 + nn), p3 = *(const f32x4*)(hp + 3 * 5632 + nn);
            const f32x4 w0 = *(const f32x4*)(cw + cc), w1 = *(const f32x4*)(cw + 5632 + cc), w2 = *(const f32x4*)(cw + 2 * 5632 + cc), bb = *(const f32x4*)(cb + cc);
            r[p] = (j == 0) ? (bb + w2 * h0 + w1 * p3 + w0 * p2) : (bb + w2 * h1 + w1 * h0 + w0 * p3);
        }
        u32x2 w; w.x = pk2(silu_f(r[0][0]) * r[1][0], silu_f(r[0][1]) * r[1][1]); w.y = pk2(silu_f(r[0][2]) * r[1][2], silu_f(r[0][3]) * r[1][3]);
        *(u32x2*)(g + (size_t)(run * 128 + j) * DFF + col) = w;
    }
    asm volatile("s_waitcnt vmcnt(0)" ::: "memory");
    __syncthreads();
}

__device__ __forceinline__ void final_phase(int vcu, int G, int wave, int lane, float* xf, const float* ss4, const float* gain) {
    const int gw = vcu * NWAVES + wave, NGW = G * NWAVES;
    f32x4 gv[4];
#pragma unroll
    for (int j = 0; j < 4; ++j) gv[j] = *(const f32x4*)(gain + 4 * lane + 256 * j);
    for (int m = gw; m < M; m += NGW) {
        const float rs = pg8::rstd_of(ss4, m);
        f32x4* xr = (f32x4*)(xf + (size_t)m * D) + lane;
#pragma unroll
        for (int j = 0; j < 4; ++j) { const f32x4 v = xr[64 * j]; xr[64 * j] = v * rs * gv[j]; }
    }
}

struct TJob { const float* W; int ldw; int K; int ncols_valid; const float* gain; bf16_t* dst; };
__device__ __forceinline__ void transpose_item(const float* W, int ldw, int K, int k0, int srccol0, int ncols_valid, const float* gain, float scale, bf16_t* dst, int drow0, LAS float* scr, int lane) {
    const int n = lane & 31; const bool ok = (srccol0 + n) < ncols_valid;
#pragma unroll 8
    for (int i = 0; i < 32; ++i) { const int kk = 2 * i + (lane >> 5);
        float v = ok ? W[(size_t)(k0 + kk) * ldw + srccol0 + n] : 0.f;
        if (gain) v *= gain[k0 + kk];
        scr[kk * 33 + n] = v * scale; }
    asm volatile("s_waitcnt lgkmcnt(0)" ::: "memory");
    const int c = lane & 7;
#pragma unroll
    for (int j = 0; j < 4; ++j) { const int nn = (lane >> 3) + 8 * j; const LAS float* s = scr + (8 * c) * 33 + nn;
        u32x4 o; o.x = pk2(s[0 * 33], s[1 * 33]); o.y = pk2(s[2 * 33], s[3 * 33]); o.z = pk2(s[4 * 33], s[5 * 33]); o.w = pk2(s[6 * 33], s[7 * 33]);
        *(u32x4*)(dst + (size_t)(drow0 + nn) * K + k0 + 8 * c) = o; }
    asm volatile("s_waitcnt lgkmcnt(0)" ::: "memory");
}
__device__ __forceinline__ float row_to_bf16(const float* xrow, bf16_t* orow, int lane) {
    const f32x4* xr = (const f32x4*)xrow + lane;
    f32x4 v[4]; float s = 0.f;
#pragma unroll
    for (int j = 0; j < 4; ++j) { v[j] = xr[64 * j]; s += (v[j][0] * v[j][0] + v[j][1] * v[j][1]) + (v[j][2] * v[j][2] + v[j][3] * v[j][3]); }
    u32x2* o8 = (u32x2*)orow + lane;
#pragma unroll
    for (int j = 0; j < 4; ++j) { u32x2 w; w.x = pk2(v[j][0], v[j][1]); w.y = pk2(v[j][2], v[j][3]); o8[64 * j] = w; }
    return wave_sum(s);
}

namespace attn_body {
using bf16 = __hip_bfloat16;
constexpr int NW = 8, QBLK = 32, QB = QBLK * NW, KVBLK = 64;
__device__ __forceinline__ int crow(int r, int hi) { return (r & 3) + 8 * (r >> 2) + 4 * hi; }
#define SBAR() __builtin_amdgcn_sched_barrier(0)
__device__ __forceinline__ void cmask(f32x16& p0, f32x16& p1, int jb, int qrel, int hi) {
    const float NEG = -INFINITY; int kb = 64 * jb + 4 * hi;
#pragma unroll
    for (int r = 0; r < 16; ++r) { int kv = kb + (r & 3) + 8 * (r >> 2); if (kv > qrel) p0[r] = NEG; if (kv + 32 > qrel) p1[r] = NEG; }
}
constexpr int NSLOT = 3, SLOTB = 8192;
constexpr int LDS_K = 0, LDS_V = NSLOT * SLOTB, LDS_WS = 2 * NSLOT * SLOTB, LDS_OST = LDS_WS + NW * 64 * 4, LDS_ATT = LDS_OST + NW * 4096;
constexpr int LDS_BIAS = LDS_ATT, LDS_WTOT = LDS_BIAS + 8192, ATTN_LDS_BYTES = LDS_WTOT + 64;
__device__ __forceinline__ void glds16(const void* gsrc, unsigned lds_dst) { unsigned keep;
    asm volatile("s_mov_b32 %0, m0\n\ts_mov_b32 m0, %2\n\ts_nop 0\n\tglobal_load_lds_dwordx4 %1, off\n\ts_mov_b32 m0, %0" : "=&s"(keep) : "v"(gsrc), "s"(lds_dst) : "memory"); }
#define WAIT_BAR(N) asm volatile("s_waitcnt vmcnt(" #N ") lgkmcnt(0)\n\ts_barrier" ::: "memory")
typedef __attribute__((address_space(3))) const char* lds_cptr;
typedef short v4i16_t __attribute__((ext_vector_type(4)));
__device__ __forceinline__ void kload8(bf16x8* kf, lds_cptr kp) {
    kf[0] = *(const LAS bf16x8*)(kp);        kf[1] = *(const LAS bf16x8*)(kp + 512);
    kf[2] = *(const LAS bf16x8*)(kp + 2048); kf[3] = *(const LAS bf16x8*)(kp + 2560);
    kf[4] = *(const LAS bf16x8*)(kp + 4096); kf[5] = *(const LAS bf16x8*)(kp + 4608);
    kf[6] = *(const LAS bf16x8*)(kp + 6144); kf[7] = *(const LAS bf16x8*)(kp + 6656);
}
__device__ __forceinline__ void kload2(bf16x8* kf, lds_cptr kp, int j) { kf[2 * j] = *(const LAS bf16x8*)(kp + j * 2048); kf[2 * j + 1] = *(const LAS bf16x8*)(kp + j * 2048 + 512); }
__device__ __forceinline__ s16x4 vtr(lds_cptr p) { return __builtin_bit_cast(s16x4, __builtin_amdgcn_ds_read_tr16_b64_v4i16((LAS v4i16_t*)p)); }
#define MX3(a, b, c) __builtin_fmaxf(__builtin_fmaxf((a), (b)), (c))
__device__ __forceinline__ float rowmax(const f32x16& p0, const f32x16& p1) {
    float a = MX3(p0[0], p0[1], p1[0]), b = MX3(p0[2], p0[3], p1[1]); a = MX3(a, p1[2], p1[3]);
#pragma unroll
    for (int r = 4; r < 16; r += 4) { a = MX3(a, p0[r], p0[r + 1]); b = MX3(b, p0[r + 2], p0[r + 3]); a = MX3(a, p1[r], p1[r + 1]); b = MX3(b, p1[r + 2], p1[r + 3]); }
    float m = __builtin_fmaxf(a, b); auto rr = __builtin_amdgcn_permlane32_swap(__float_as_uint(m), __float_as_uint(m), false, false);
    return __builtin_fmaxf(__uint_as_float(rr[0]), __uint_as_float(rr[1]));
}
__device__ __forceinline__ void pv(f32x16* o, int vb, bf16x8 pa0, bf16x8 pa1, bf16x8 pa2, bf16x8 pa3) {
#pragma unroll
    for (int d0 = 0; d0 < 2; ++d0) { s16x4 lo[4], hi[4];
#pragma unroll
        for (int ks = 0; ks < 4; ++ks) {
            asm volatile("ds_read_b64_tr_b16 %0,%1 offset:%c2" : "=&v"(lo[ks]) : "v"(vb), "i"(d0 * 4096 + ks * 1024) : "memory");
            asm volatile("ds_read_b64_tr_b16 %0,%1 offset:%c2" : "=&v"(hi[ks]) : "v"(vb), "i"(d0 * 4096 + ks * 1024 + 512) : "memory"); }
        asm volatile("s_waitcnt lgkmcnt(0)" ::: "memory"); SBAR();
#define PK(k) (bf16x8){lo[k][0], lo[k][1], lo[k][2], lo[k][3], hi[k][0], hi[k][1], hi[k][2], hi[k][3]}
        o[d0] = __builtin_amdgcn_mfma_f32_32x32x16_bf16(pa0, PK(0), o[d0], 0, 0, 0);
        o[d0] = __builtin_amdgcn_mfma_f32_32x32x16_bf16(pa1, PK(1), o[d0], 0, 0, 0);
        o[d0] = __builtin_amdgcn_mfma_f32_32x32x16_bf16(pa2, PK(2), o[d0], 0, 0, 0);
        o[d0] = __builtin_amdgcn_mfma_f32_32x32x16_bf16(pa3, PK(3), o[d0], 0, 0, 0);
#undef PK
    }
}

template <bool FOX, int THRL, int qp, int kp, int vp, int op>
__device__ __forceinline__ void attn_unit(const bf16* Q, const bf16* __restrict__ K, const bf16* __restrict__ V, bf16* O, int NT, char* shm) {
    int tid = threadIdx.x; asm volatile("" : "+v"(tid));
    const int lane = tid & 63, r32 = lane & 31, hi = lane >> 5; const int wid = __builtin_amdgcn_readfirstlane(tid >> 6);
    const bf16* Qw = Q + (long)(wid * QBLK) * qp;
    const unsigned lds0 = (unsigned)(uintptr_t)shm;
    float* wsf = (float*)(shm + LDS_WS) + wid * 64;
    const bf16* ksrc = K + (long)lane * kp + wid * 8;
    const bf16* vsrc = V + (long)(16 * (wid & 3) + (lane >> 2)) * vp + (wid >> 2) * 32 + (lane & 3) * 8;
    const unsigned kdst = lds0 + LDS_K + wid * 1024, vdst = lds0 + LDS_V + wid * 1024;
#define DMA_K(t, slot) glds16(ksrc + (long)(t) * KVBLK * kp, (unsigned)__builtin_amdgcn_readfirstlane(kdst + (slot)))
#define DMA_V(t, slot) glds16(vsrc + (long)(t) * KVBLK * vp, (unsigned)__builtin_amdgcn_readfirstlane(vdst + (slot)))
    const int vb0 = (int)(lds0 + LDS_V) + ((lane >> 4) & 1) * 32 + (lane & 3) * 8 + (4 * hi + ((lane & 15) >> 2)) * 64;
    const char* Kbase = shm + LDS_K; bf16x8 kf[8];
    const lds_cptr shm3 = (lds_cptr)shm; const lds_cptr kp0 = shm3 + LDS_K + hi * 1024 + r32 * 16; const lds_cptr vp0 = shm3 + LDS_V + ((lane >> 4) & 1) * 32 + (lane & 3) * 8 + (4 * hi + ((lane & 15) >> 2)) * 64;
    const LAS float* biasL = (const LAS float*)(shm3 + LDS_BIAS) + 4 * hi;
    DMA_K(0, 0); DMA_V(0, 0); DMA_K(1, SLOTB);
    bf16x8 qr[4];
#pragma unroll
    for (int d0 = 0; d0 < 4; ++d0) qr[d0] = *reinterpret_cast<const bf16x8*>(&Qw[(long)r32 * qp + d0 * 16 + hi * 8]);
    const int qrel = wid * QBLK + r32;
    float mhat = 0.f, l_reg = 0.f; f32x16 o[2]; o[0] = f32x16{}; o[1] = f32x16{};
    float sq = 0.f;
    if (FOX) sq = -((const LAS float*)(shm3 + LDS_BIAS))[(NT - 4) * KVBLK + qrel];
    bool resc = false;
#define CINIT(C0, C1, t) do { if (FOX) { const LAS float* bp_ = biasL + (t) * KVBLK; \
        _Pragma("unroll") for (int a_ = 0; a_ < 4; ++a_) { const f32x4 b0_ = *(const LAS f32x4*)(bp_ + 8 * a_), b1_ = *(const LAS f32x4*)(bp_ + 32 + 8 * a_); \
            _Pragma("unroll") for (int e_ = 0; e_ < 4; ++e_) { C0[4 * a_ + e_] = b0_[e_] + sq; C1[4 * a_ + e_] = b1_[e_] + sq; } } } \
      else { _Pragma("unroll") for (int r_ = 0; r_ < 16; ++r_) { C0[r_] = sq; C1[r_] = sq; } } } while (0)
#define DECIDE(C0, C1) do { float rm = rowmax(C0, C1); resc = false; \
      if (__builtin_expect(__any(rm > (float)THRL), 0)) { const float dl = __builtin_fmaxf(rm, 0.f); mhat += dl; sq -= dl; \
        _Pragma("unroll") for (int r = 0; r < 16; ++r) { C0[r] -= dl; C1[r] -= dl; } \
        const float f = __builtin_amdgcn_exp2f(-dl); l_reg *= f; if (hi == 0) wsf[r32] = f; resc = true; } } while (0)
#define RESC() do { if (resc) { asm volatile("s_waitcnt lgkmcnt(0)" ::: "memory"); \
      _Pragma("unroll") for (int d_ = 0; d_ < 2; ++d_) _Pragma("unroll") for (int r = 0; r < 16; ++r) o[d_][r] *= wsf[crow(r, hi)]; } } while (0)
#define CMASK(P0, P1, t) do { if (FOX) { int jb_ = (t) - (NT - 4); if (jb_ >= 0) cmask(P0, P1, jb_, qrel, hi); } } while (0)
    f32x16 pA0, pA1, pB0, pB1;
    int sl_prev = 0, sl_cur = 0, sl_next = SLOTB;
#define ROT() do { sl_prev = sl_cur; sl_cur = sl_next; sl_next = (sl_next == (NSLOT - 1) * SLOTB) ? 0 : sl_next + SLOTB; } while (0)
    DMA_K(2, 2 * SLOTB);
    WAIT_BAR(3);
    CINIT(pA0, pA1, 0);
    {
        const char* kb = Kbase + hi * 1024 + r32 * 16;
#pragma unroll
        for (int d0 = 0; d0 < 4; ++d0) {
            const bf16x8 b0 = *reinterpret_cast<const bf16x8*>(kb + d0 * 2048);
            const bf16x8 b1 = *reinterpret_cast<const bf16x8*>(kb + d0 * 2048 + 512);
            pA0 = __builtin_amdgcn_mfma_f32_32x32x16_bf16(b0, qr[d0], pA0, 0, 0, 0); pA1 = __builtin_amdgcn_mfma_f32_32x32x16_bf16(b1, qr[d0], pA1, 0, 0, 0); }
    }
    CMASK(pA0, pA1, 0);
    DECIDE(pA0, pA1);
#pragma unroll
    for (int r = 0; r < 16; ++r) { pA0[r] = __builtin_amdgcn_exp2f(pA0[r]); pA1[r] = __builtin_amdgcn_exp2f(pA1[r]); }
    WAIT_BAR(0);
    DMA_K(3, 0); DMA_V(1, SLOTB);
    ROT();
    kload8(kf, kp0 + sl_cur);
    WAIT_BAR(2);
    s16x4 vlo[8], vhi[8]; u32x4 pw0, pw1, pw2, pw3;
#define PKW(P, B) pk2(P[B], P[B + 1])
#define PAF(k) __builtin_bit_cast(bf16x8, pw##k)
#define VFR(i) (bf16x8){vlo[i][0], vlo[i][1], vlo[i][2], vlo[i][3], vhi[i][0], vhi[i][1], vhi[i][2], vhi[i][3]}
#define PIN(x) asm volatile("" : "+v"(x))
#define GAPA(MF, A0, A1, A2, A3, W0, W1, PW) do { MF; sacc += A0; sacc += A1; sacc += A2; sacc += A3; PIN(sacc); W0; W1; PIN(PW); SBAR(); } while (0)
#define EX(v) __builtin_amdgcn_exp2f(v)
#define GAPB(MF, X, B) do { MF; X[B] = EX(X[B]); X[B + 1] = EX(X[B + 1]); X[B + 2] = EX(X[B + 2]); X[B + 3] = EX(X[B + 3]); PIN(X); SBAR(); } while (0)
#define VRD(i) do { vlo[i] = vtr(vp_ + (((i) >> 2) * 4096 + ((i) & 3) * 1024)); vhi[i] = vtr(vp_ + (((i) >> 2) * 4096 + ((i) & 3) * 1024 + 512)); } while (0)
#define KRD(G, j) do { if (G) { kload2(kf, kp0 + sl_next, j); SBAR(); } } while (0)
#define STEP(C0, C1, P0, P1, t, GK, GV, GL) do { SBAR(); \
    const lds_cptr vp_ = vp0 + sl_prev; \
    CINIT(C0, C1, t); SBAR(); \
    VRD(0); SBAR(); float sacc = (P0[0] + P0[1]); \
    GAPA(C0 = __builtin_amdgcn_mfma_f32_32x32x16_bf16(kf[0], qr[0], C0, 0, 0, 0), P0[2], P0[3], P0[4], P0[5],     pw0[0] = PKW(P0, 0), pw0[1] = PKW(P0, 2), pw0); \
    VRD(4); SBAR(); GAPA(C1 = __builtin_amdgcn_mfma_f32_32x32x16_bf16(kf[1], qr[0], C1, 0, 0, 0), P0[6], P0[7], P0[8], P0[9],     pw0[2] = PKW(P0, 4), pw0[3] = PKW(P0, 6), pw0); \
    VRD(1); SBAR(); GAPA(C0 = __builtin_amdgcn_mfma_f32_32x32x16_bf16(kf[2], qr[1], C0, 0, 0, 0),   P0[10], P0[11], P0[12], P0[13], pw1[0] = PKW(P0, 8), pw1[1] = PKW(P0, 10), pw1); \
    VRD(5); SBAR(); GAPA(C1 = __builtin_amdgcn_mfma_f32_32x32x16_bf16(kf[3], qr[1], C1, 0, 0, 0),   P0[14], P0[15], P1[0], P1[1],   pw1[2] = PKW(P0, 12), pw1[3] = PKW(P0, 14), pw1); \
    VRD(2); SBAR(); GAPA(C0 = __builtin_amdgcn_mfma_f32_32x32x16_bf16(kf[4], qr[2], C0, 0, 0, 0),   P1[2], P1[3], P1[4], P1[5],     pw2[0] = PKW(P1, 0), pw2[1] = PKW(P1, 2), pw2); \
    VRD(6); SBAR(); GAPA(C1 = __builtin_amdgcn_mfma_f32_32x32x16_bf16(kf[5], qr[2], C1, 0, 0, 0),   P1[6], P1[7], P1[8], P1[9],     pw2[2] = PKW(P1, 4), pw2[3] = PKW(P1, 6), pw2); \
    VRD(3); SBAR(); GAPA(C0 = __builtin_amdgcn_mfma_f32_32x32x16_bf16(kf[6], qr[3], C0, 0, 0, 0),   P1[10], P1[11], P1[12], P1[13], pw3[0] = PKW(P1, 8), pw3[1] = PKW(P1, 10), pw3); \
    VRD(7); SBAR(); GAPA(C1 = __builtin_amdgcn_mfma_f32_32x32x16_bf16(kf[7], qr[3], C1, 0, 0, 0),   P1[14], P1[15], 0.f, 0.f,       pw3[2] = PKW(P1, 12), pw3[3] = PKW(P1, 14), pw3); \
    l_reg += sacc; \
    if (GK) { DMA_K((t) + 3, sl_cur); } if (GV) { DMA_V((t) + 1, sl_next); } \
    CMASK(C0, C1, t); \
    DECIDE(C0, C1); \
    SBAR(); \
    GAPB(o[0] = __builtin_amdgcn_mfma_f32_32x32x16_bf16(PAF(0), VFR(0), o[0], 0, 0, 0), C0, 0); \
    GAPB(o[1] = __builtin_amdgcn_mfma_f32_32x32x16_bf16(PAF(0), VFR(4), o[1], 0, 0, 0), C0, 4); \
    KRD(GL, 0); GAPB(o[0] = __builtin_amdgcn_mfma_f32_32x32x16_bf16(PAF(1), VFR(1), o[0], 0, 0, 0), C0, 8); \
    KRD(GL, 1); GAPB(o[1] = __builtin_amdgcn_mfma_f32_32x32x16_bf16(PAF(1), VFR(5), o[1], 0, 0, 0), C0, 12); \
    KRD(GL, 2); GAPB(o[0] = __builtin_amdgcn_mfma_f32_32x32x16_bf16(PAF(2), VFR(2), o[0], 0, 0, 0), C1, 0); \
    KRD(GL, 3); GAPB(o[1] = __builtin_amdgcn_mfma_f32_32x32x16_bf16(PAF(2), VFR(6), o[1], 0, 0, 0), C1, 4); \
    GAPB(o[0] = __builtin_amdgcn_mfma_f32_32x32x16_bf16(PAF(3), VFR(3), o[0], 0, 0, 0), C1, 8); \
    GAPB(o[1] = __builtin_amdgcn_mfma_f32_32x32x16_bf16(PAF(3), VFR(7), o[1], 0, 0, 0), C1, 12); \
    } while (0)
    int t = 1;
    for (; t + 5 < NT; t += 2) {
        STEP(pB0, pB1, pA0, pA1, t, true, true, true);     WAIT_BAR(2); RESC(); ROT();
        STEP(pA0, pA1, pB0, pB1, t + 1, true, true, true); WAIT_BAR(2); RESC(); ROT();
    }
#define ENDW(tt) do { if ((tt) + 3 < NT) { WAIT_BAR(2); } else if ((tt) + 2 < NT) { WAIT_BAR(1); } else { WAIT_BAR(0); } } while (0)
    for (; t + 1 < NT; t += 2) {
        STEP(pB0, pB1, pA0, pA1, t, (t + 3 < NT), (t + 1 < NT), (t + 1 < NT));       ENDW(t);     RESC(); ROT();
        STEP(pA0, pA1, pB0, pB1, t + 1, (t + 4 < NT), (t + 2 < NT), (t + 2 < NT));   ENDW(t + 1); RESC(); ROT();
    }
    STEP(pB0, pB1, pA0, pA1, NT - 1, false, false, false); RESC();
    { float sacc = pB0[0] + pB0[1];
#pragma unroll
      for (int r = 2; r < 16; ++r) sacc += pB0[r];
#pragma unroll
      for (int r = 0; r < 16; ++r) sacc += pB1[r];
      l_reg += sacc;
      pw0 = (u32x4){PKW(pB0, 0), PKW(pB0, 2), PKW(pB0, 4), PKW(pB0, 6)}; pw1 = (u32x4){PKW(pB0, 8), PKW(pB0, 10), PKW(pB0, 12), PKW(pB0, 14)};
      pw2 = (u32x4){PKW(pB1, 0), PKW(pB1, 2), PKW(pB1, 4), PKW(pB1, 6)}; pw3 = (u32x4){PKW(pB1, 8), PKW(pB1, 10), PKW(pB1, 12), PKW(pB1, 14)};
      SBAR(); pv(o, vb0 + sl_cur, PAF(0), PAF(1), PAF(2), PAF(3)); }
    { auto rr = __builtin_amdgcn_permlane32_swap(__float_as_uint(l_reg), __float_as_uint(l_reg), false, false); l_reg = __uint_as_float(rr[0]) + __uint_as_float(rr[1]); }
    if (hi == 0) wsf[32 + r32] = l_reg; asm volatile("s_waitcnt lgkmcnt(0)" ::: "memory");
    float rli[16];
#pragma unroll
    for (int r = 0; r < 16; ++r) rli[r] = __builtin_amdgcn_rcpf(wsf[32 + crow(r, hi)]);
    bf16* Ow = O + (long)(wid * QBLK) * op;
    { bf16* stg = (bf16*)(shm + LDS_OST) + wid * 2048;
#pragma unroll
      for (int r = 0; r < 16; ++r) { const int orow = crow(r, hi);
#pragma unroll
          for (int d0 = 0; d0 < 2; ++d0) stg[orow * 64 + d0 * 32 + r32] = __float2bfloat16(o[d0][r] * rli[r]); }
      asm volatile("s_waitcnt lgkmcnt(0)" ::: "memory");
#pragma unroll
      for (int i = 0; i < 4; ++i) { const int row = i * 8 + (lane >> 3), ch = lane & 7; const u32x4 v = *(const u32x4*)(stg + row * 64 + ch * 8); *(u32x4*)(Ow + (long)row * op + ch * 8) = v; } }
    asm volatile("s_waitcnt lgkmcnt(0)\n\ts_barrier" ::: "memory");
#undef DMA_K
#undef DMA_V
#undef CINIT
#undef DECIDE
#undef RESC
#undef CMASK
#undef ROT
#undef PKW
#undef PAF
#undef VFR
#undef PIN
#undef GAPA
#undef GAPB
#undef EX
#undef VRD
#undef KRD
#undef STEP
#undef ENDW
}

__device__ __forceinline__ void bias_scan(const float* lf, int n, char* shm) {
    int tid = threadIdx.x; asm volatile("" : "+v"(tid));
    const int lane = tid & 63, wid = tid >> 6;
    LAS float* bias = (LAS float*)((lds_cptr)shm + LDS_BIAS); LAS float* wtot = (LAS float*)((lds_cptr)shm + LDS_WTOT);
    f32x4 v = (f32x4){0.f, 0.f, 0.f, 0.f};
    if (4 * tid < n) v = *(const f32x4*)(lf + 4 * tid);
    v[1] += v[0]; v[2] += v[1]; v[3] += v[2];
    float s = v[3];
#pragma unroll
    for (int o = 1; o < 64; o <<= 1) { const float u = __shfl_up(s, o); if (lane >= o) s += u; }
    if (lane == 63) wtot[wid] = s;
    __syncthreads();
    float base = s - v[3];
    for (int w = 0; w < wid; ++w) base += wtot[w];
    if (4 * tid < n) { f32x4 r; r[0] = -(base + v[0]) * LOG2E; r[1] = -(base + v[1]) * LOG2E; r[2] = -(base + v[2]) * LOG2E; r[3] = -(base + v[3]) * LOG2E; *(LAS f32x4*)(bias + 4 * tid) = r; }
    __syncthreads();
}
#undef SBAR
#undef WAIT_BAR
#undef MX3
}

constexpr int GM_VSTRIDE = 416;
constexpr int GM_RSTD_OFF = 128 * GM_VSTRIDE;
__device__ __forceinline__ void gmlp_unit(int b, int n, int g, const bf16_t* z, const float* vssp, const float* w_s, const float* b_s, const float* vgain, bf16_t* mix, char* shm) {
    typedef __attribute__((address_space(3))) char* lds_ptr;
    int tid = threadIdx.x; asm volatile("" : "+v"(tid));
    const int lane = tid & 63, fr = lane & 15, fq = lane >> 4; const int wid = __builtin_amdgcn_readfirstlane(tid >> 6);
    const int t0 = b * SEQ + n * 128;
    lds_ptr sh = (lds_ptr)shm; LAS float* rstd = (LAS float*)(sh + GM_RSTD_OFF);
#pragma unroll
    for (int i = 0; i < 6; ++i) { const int idx = tid + NTHR * i, row = idx / 24, ch = idx % 24;
        const u32x4 w = *(const u32x4*)(z + (size_t)(t0 + row) * ZW + TOK + 192 * g + ch * 8);
        const int p = ch >> 2, a = ch & 3; lds_ptr dst = sh + row * GM_VSTRIDE + p * 64 + a * 8;
        *(LAS u32x2*)(dst) = (u32x2){w.x, w.y}; *(LAS u32x2*)(dst + 32) = (u32x2){w.z, w.w}; }
    if (tid < 128) { const float* p = vssp + (size_t)(t0 + tid) * 12; float s = 0.f;
#pragma unroll
        for (int i = 0; i < 12; ++i) s += p[i];
        rstd[tid] = rsqrtf(s * (1.0f / TOK) + EPS); }
    __syncthreads();
    f32x4 acc[12];
#pragma unroll
    for (int i = 0; i < 12; ++i) acc[i] = (f32x4){0.f, 0.f, 0.f, 0.f};
    const int trow = 16 * wid + fr;
    const int nks = (wid >> 1) + 1;
    const float* wrow = w_s + ((size_t)g * 128 + trow) * 128;
    for (int ks = 0; ks < nks; ++ks) {
        const int s0 = 32 * ks + 4 * fq;
        const f32x4 w0 = *(const f32x4*)(wrow + s0), w1 = *(const f32x4*)(wrow + s0 + 16);
        const f32x4 r0 = *(const LAS f32x4*)(rstd + s0), r1 = *(const LAS f32x4*)(rstd + s0 + 16);
        float wv[8];
#pragma unroll
        for (int e = 0; e < 4; ++e) { wv[e] = (s0 + e <= trow) ? w0[e] * r0[e] : 0.f; wv[4 + e] = (s0 + 16 + e <= trow) ? w1[e] * r1[e] : 0.f; }
        u32x4 wp; wp.x = pk2(wv[0], wv[1]); wp.y = pk2(wv[2], wv[3]); wp.z = pk2(wv[4], wv[5]); wp.w = pk2(wv[6], wv[7]);
        const bf16x8 wfrag = __builtin_bit_cast(bf16x8, wp);
        lds_ptr vbase = sh + (32 * ks + 4 * fq + (fr >> 2)) * GM_VSTRIDE + (fr & 3) * 8;
#pragma unroll
        for (int nb = 0; nb < 12; ++nb) {
            const s16x4 lo = __builtin_bit_cast(s16x4, __builtin_amdgcn_ds_read_tr16_b64_v4i16((LAS attn_body::v4i16_t*)(vbase + (nb >> 1) * 64 + (nb & 1) * 32)));
            const s16x4 hi = __builtin_bit_cast(s16x4, __builtin_amdgcn_ds_read_tr16_b64_v4i16((LAS attn_body::v4i16_t*)(vbase + 16 * GM_VSTRIDE + (nb >> 1) * 64 + (nb & 1) * 32)));
            const bf16x8 vfrag = (bf16x8){lo[0], lo[1], lo[2], lo[3], hi[0], hi[1], hi[2], hi[3]};
            acc[nb] = __builtin_amdgcn_mfma_f32_16x16x32_bf16(vfrag, wfrag, acc[nb], 0, 0, 0);
        }
    }
    const float bs = b_s[g * 128 + trow];
    const size_t rowoff = (size_t)(t0 + trow);
#pragma unroll
    for (int p = 0; p < 6; ++p) {
        const int c0 = 192 * g + 32 * p + 8 * fq;
        const f32x4 g0 = *(const f32x4*)(vgain + c0), g1 = *(const f32x4*)(vgain + c0 + 4);
        const u32x4 uu = *(const u32x4*)(z + rowoff * ZW + c0);
        f32x4 m0 = acc[2 * p] * g0 + bs, m1 = acc[2 * p + 1] * g1 + bs;
        u32x4 w; w.x = pk2(bf_lo(uu.x) * m0[0], bf_hi(uu.x) * m0[1]); w.y = pk2(bf_lo(uu.y) * m0[2], bf_hi(uu.y) * m0[3]);
        w.z = pk2(bf_lo(uu.z) * m1[0], bf_hi(uu.z) * m1[1]); w.w = pk2(bf_lo(uu.w) * m1[2], bf_hi(uu.w) * m1[3]);
        *(u32x4*)(mix + rowoff * D + c0) = w;
    }
    __syncthreads();
}

constexpr int N_PHASES = 12;
#ifndef MK_REP_PHASE
#define MK_REP_PHASE 0
#endif
#ifndef MK_DBG_PTR
#define MK_DBG_PTR nullptr
#endif
struct Args { const float* in[29]; float* out; unsigned char* ws; int ph_lo, ph_hi, rep, pad; };

__global__ void __launch_bounds__(NTHR, 2) mk_fwd(Args args) {
    extern __shared__ __attribute__((aligned(16))) unsigned char lds[];
    LAS unsigned char* L = (LAS unsigned char*)lds;
    volatile LAS unsigned* MISC = (volatile LAS unsigned*)(L + MISC_OFF);
    const int tid = threadIdx.x, lane = tid & 63, wave = __builtin_amdgcn_readfirstlane(tid >> 6);
    const int G = gridDim.x; const int bx = blockIdx.x; const int vcu = (G % 8 == 0) ? (bx % 8) * (G / 8) + bx / 8 : bx;
    unsigned char* ws = args.ws;
#define in args.in
#define xf args.out
#define P_BF(off) ((bf16_t*)(ws + (off)))
#define P_F32(off) ((float*)(ws + (off)))
#define Win P_BF(WS_WIN)
#define Wmem P_BF(WS_WMEM)
#define AWout P_BF(WS_AWOUT)
#define Affi P_BF(WS_AFFI)
#define Affo P_BF(WS_AFFO)
#define Kvq P_BF(WS_KVQ)
#define BWout P_BF(WS_BWOUT)
#define Bffi P_BF(WS_BFFI)
#define Bffo P_BF(WS_BFFO)
#define xb P_BF(WS_XB)
#define mix P_BF(WS_MIX)
#define memb P_BF(WS_MEMB)
#define memkv P_BF(WS_MEMKV)
#define qmem P_BF(WS_QMEM)
#define ss4 P_F32(WS_SS4)
#define memss P_F32(WS_MEMSS)
#define vssp P_F32(WS_VSSP)
#define lf P_F32(WS_LF)
#define halo P_F32(WS_HALO)
#define zb P_BF(WS_R1)
#define gb P_BF(WS_R1)
#define kb P_BF(WS_KB)
#define vb P_BF(WS_VB)
#define qb P_BF(WS_QB)
    if (tid < 64) ((LAS unsigned*)(L + MISC_OFF))[tid] = 0u;
    __syncthreads();
    const int lo = args.ph_lo, hi = args.ph_hi;
    const bool use_bar = (hi - lo) > 1;
    XcdBarrier bar; bar.bar = (unsigned*)(ws + WS_CTL) + 4096; bar.x = 0; bar.st = nullptr;
    if (use_bar) bar = xcd_barrier_post((unsigned*)(ws + WS_CTL) + 4096, MISC + 8);
#define IN(k) (lo <= (k) && (k) < hi)
#if MK_REP_PHASE
#define REPS(k) for (int rep_ = 0; rep_ < (IN(k) ? (((args.rep >> (k)) & 1) ? 2 : 1) : 0); ++rep_)
#else
#define REPS(k) if (IN(k))
#endif
#define SEAM(k) do { if (IN(k) && IN((k) + 1)) xcd_barrier(bar); } while (0)

    REPS(0) {
        LAS float* scr = (LAS float*)(L + wave * 16384);
        const int gw = vcu * NWAVES + wave, NGW = G * NWAVES;
        constexpr int I0 = 16 * 56, I1 = 16 * 32, I2 = 16 * 32, I3 = 16 * 176, I4 = 44 * 32, I5 = 16 * 88, I6 = 16 * 32, I7 = 16 * 176, I8 = 44 * 32;
        constexpr int NITEMS = I0 + I1 + I2 + I3 + I4 + I5 + I6 + I7 + I8;
        for (int it = gw; it < NITEMS; it += NGW) {
            int r = it;
            if (r < I0) { const int nb = r % 56, kb_ = r / 56; transpose_item(in[3], ZW, D, 64 * kb_, 32 * nb, ZW, in[2], (32 * nb >= 1536) ? C2 : 1.f, Win, 32 * nb, scr, lane); continue; } r -= I0;
            if (r < I1) { const int nb = r % 32, kb_ = r / 32; const bool lb = nb >= 16;
                transpose_item(lb ? in[21] : in[8], 512, D, 64 * kb_, 32 * (nb & 15), 512, lb ? in[20] : in[7], 1.f, Wmem, 32 * nb, scr, lane); continue; } r -= I1;
            if (r < I2) { const int nb = r % 32, kb_ = r / 32; transpose_item(in[9], D, D, 64 * kb_, 32 * nb, D, nullptr, 1.f, AWout, 32 * nb, scr, lane); continue; } r -= I2;
            if (r < I3 || (r >= I3 + I4 + I5 + I6 && r < I3 + I4 + I5 + I6 + I7)) { const bool lb = r >= I3; if (lb) r -= I3 + I4 + I5 + I6;
                const int nb = r % 176, kb_ = r / 176; const int n0 = 32 * nb, q = n0 >> 8, i = n0 & 255; const int src = (i < 128) ? (128 * q + i) : (DFF + 128 * q + (i - 128));
                transpose_item(lb ? in[24] : in[11], 5632, D, 64 * kb_, src, 5632, lb ? in[23] : in[10], 1.f, lb ? Bffi : Affi, n0, scr, lane); continue; } r -= I3;
            if (r < I4) { const int nb = r % 32, kb_ = r / 32; transpose_item(in[14], D, DFF, 64 * kb_, 32 * nb, D, nullptr, 1.f, Affo, 32 * nb, scr, lane); continue; } r -= I4;
            if (r < I5) { const int nb = r % 88, kb_ = r / 88; const int n0 = 32 * nb;
                if (n0 < 1536) transpose_item(in[16], 1548, D, 64 * kb_, n0, 1548, in[15], 1.f, Kvq, n0, scr, lane);
                else if (n0 < 2560) transpose_item(in[19], D, D, 64 * kb_, n0 - 1536, D, in[18], C2, Kvq, n0, scr, lane);
                else transpose_item(in[16], 1548, D, 64 * kb_, 1536 + (n0 - 2560), (n0 == 2560) ? 1548 : 0, in[15], 1.f, Kvq, n0, scr, lane);
                continue; } r -= I5;
            if (r < I6) { const int nb = r % 32, kb_ = r / 32; transpose_item(in[22], D, D, 64 * kb_, 32 * nb, D, nullptr, 1.f, BWout, 32 * nb, scr, lane); continue; } r -= I6;
            r -= I7;
            { const int nb = r % 32, kb_ = r / 32; transpose_item(in[27], D, DFF, 64 * kb_, 32 * nb, D, nullptr, 1.f, Bffo, 32 * nb, scr, lane); }
        }
        for (int m = gw; m < M; m += NGW) { const float s = row_to_bf16(in[0] + (size_t)m * D, xb + (size_t)m * D, lane); if (lane == 0) *(f32x4*)(ss4 + (size_t)m * 4) = (f32x4){s, 0.f, 0.f, 0.f}; }
        for (int m = gw; m < MROWS; m += NGW) { const float s = row_to_bf16(in[1] + (size_t)m * D, memb + (size_t)m * D, lane); if (lane == 0) *(f32x4*)(memss + (size_t)m * 4) = (f32x4){s, 0.f, 0.f, 0.f}; }
    }
    SEAM(0);
    REPS(1) {
        pg8::Sched S; S.init(M, ZW, D, G, bx, xb, Win); S.extra(MROWS, 1024, memb, Wmem);
        pg8::EpiIn E{zb, memkv, qmem, ss4, memss, vssp};
        pg8::gemm_phase<pg8::EpiIn, true, false>(L, S, E);
    }
    SEAM(1);
    REPS(2) {
        for (int uidx = vcu; uidx < 512; uidx += G) gmlp_unit(uidx >> 6, (uidx >> 2) & 15, uidx & 3, zb, vssp, in[5], in[6], in[4], mix, (char*)lds);
        for (int uidx = vcu; uidx < 256; uidx += G) { const int b = uidx >> 5, h = (uidx >> 3) & 3, qt = uidx & 7;
            const size_t row0 = (size_t)b * SEQ + qt * 256;
            attn_body::attn_unit<false, 8, MEMW, 1024, 1024, D>((const attn_body::bf16*)qmem + row0 * MEMW + 64 * h, (const attn_body::bf16*)memkv + (size_t)b * NMEM * 1024 + 64 * h,
                                           (const attn_body::bf16*)memkv + (size_t)b * NMEM * 1024 + 256 + 64 * h, (attn_body::bf16*)mix + row0 * D + TOK + 64 * h, 4, (char*)lds); }
    }
    SEAM(2);
    REPS(3) {
        pg8::Sched S; S.init(M, D, D, G, bx, mix, AWout);
        pg8::EpiRes<true, false> E{in[0], xf, xb, ss4};
        pg8::gemm_phase<pg8::EpiRes<true, false>, false, false>(L, S, E);
    }
    SEAM(3);
    REPS(4) {
        pg8::Sched S; S.init(M, 2 * DFF, D, G, bx, xb, Affi);
        pg8::EpiFfn E{gb, halo, ss4, in[12], in[13]};
        pg8::gemm_phase<pg8::EpiFfn, true, true>(L, S, E);
    }
    SEAM(4);
    if (IN(5)) {
        pg8::Sched S; S.init(M, D, DFF, G, bx, gb, Affo);
        { pg8::Unit u0; if (S.next(0, u0)) fixup_panel(u0.pm, gb, halo, in[12], in[13]); }
        pg8::EpiRes<false, false> E{nullptr, xf, xb, ss4};
        pg8::gemm_phase<pg8::EpiRes<false, false>, false, false>(L, S, E);
    }
    SEAM(5);
    REPS(6) {
        pg8::Sched S; S.init(M, 2816, D, G, bx, xb, Kvq);
        pg8::EpiKvq E{kb, vb, qb, qmem, lf, ss4, in[17]};
        pg8::gemm_phase<pg8::EpiKvq, true, false>(L, S, E);
    }
    SEAM(6);
    REPS(7) {
        for (int v = vcu; v < 256; v += G) {
            const int grp = v >> 3, k8 = v & 7;
            const unsigned tbe = k8 == 0 ? 0x000c1cu : k8 == 1 ? 0x040d1du : k8 == 2 ? 0x05081eu : k8 == 3 ? 0x011018u : k8 == 4 ? 0x021419u : k8 == 5 ? 0x06111au : k8 == 6 ? 0x091215u : 0x0a0e16u;
#pragma unroll 1
            for (int i = 0; i < 3; ++i) {
                const unsigned e = (tbe >> (8 * i)) & 0xffu; const int qb_ = (int)(e >> 2), cp = (int)(e & 3u);
                const int bh = grp * 3 + cp, b = bh / NFOX, h = bh % NFOX;
                const int NT = 4 * qb_ + 4; const size_t rowb = (size_t)b * SEQ, row0 = rowb + qb_ * 256;
                attn_body::bias_scan(lf + ((size_t)b * NFOX + h) * SEQ, NT * 64, (char*)lds);
                attn_body::attn_unit<true, 8, KVW, KVW, KVW, D>((const attn_body::bf16*)qb + row0 * KVW + 64 * h, (const attn_body::bf16*)kb + rowb * KVW + 64 * h,
                                              (const attn_body::bf16*)vb + rowb * KVW + 64 * h, (attn_body::bf16*)mix + row0 * D + 64 * h, NT, (char*)lds);
            }
        }
        for (int uidx = vcu; uidx < 256; uidx += G) { const int b = uidx >> 5, h = (uidx >> 3) & 3, qt = uidx & 7;
            const size_t row0 = (size_t)b * SEQ + qt * 256;
            attn_body::attn_unit<false, 8, MEMW, 1024, 1024, D>((const attn_body::bf16*)qmem + row0 * MEMW + 64 * h, (const attn_body::bf16*)memkv + (size_t)b * NMEM * 1024 + 512 + 64 * h,
                                           (const attn_body::bf16*)memkv + (size_t)b * NMEM * 1024 + 768 + 64 * h, (attn_body::bf16*)mix + row0 * D + TOK + 64 * h, 4, (char*)lds); }
    }
    SEAM(7);
    if (IN(8)) {
        pg8::Sched S; S.init(M, D, D, G, bx, mix, BWout);
        pg8::EpiRes<false, false> E{nullptr, xf, xb, ss4};
        pg8::gemm_phase<pg8::EpiRes<false, false>, false, false>(L, S, E);
    }
    SEAM(8);
    if (IN(9)) {
        pg8::Sched S; S.init(M, 2 * DFF, D, G, bx, xb, Bffi);
        pg8::EpiFfn E{gb, halo, ss4, in[25], in[26]};
        pg8::gemm_phase<pg8::EpiFfn, true, true>(L, S, E);
    }
    SEAM(9);
    if (IN(10)) {
        pg8::Sched S; S.init(M, D, DFF, G, bx, gb, Bffo);
        { pg8::Unit u0; if (S.next(0, u0)) fixup_panel(u0.pm, gb, halo, in[25], in[26]); }
        pg8::EpiRes<false, true> E{nullptr, xf, xb, ss4};
        pg8::gemm_phase<pg8::EpiRes<false, true>, false, false>(L, S, E);
    }
    SEAM(10);
    if (IN(11)) final_phase(vcu, G, wave, lane, xf, ss4, in[28]);
#undef IN
#undef REPS
#undef SEAM
#undef in
#undef xf
#undef Win
#undef Wmem
#undef AWout
#undef Affi
#undef Affo
#undef Kvq
#undef BWout
#undef Bffi
#undef Bffo
#undef xb
#undef mix
#undef memb
#undef memkv
#undef qmem
#undef ss4
#undef memss
#undef vssp
#undef lf
#undef halo
#undef zb
#undef gb
#undef kb
#undef vb
#undef qb
}

#ifndef MK_N_LAUNCHES
#define MK_N_LAUNCHES 1
#endif
static int mk_grid() {
    static int grid = 0;
    if (grid == 0) {
        int dev = 0, cus = 0, per_cu = 0;
        if (hipGetDevice(&dev) != hipSuccess || hipDeviceGetAttribute(&cus, hipDeviceAttributeMultiprocessorCount, dev) != hipSuccess) { fprintf(stderr, "kernel_launch: device query failed\n"); grid = -1; return grid; }
        if (hipFuncSetAttribute((const void*)mk_fwd, hipFuncAttributeMaxDynamicSharedMemorySize, LDS_BYTES) != hipSuccess) { fprintf(stderr, "kernel_launch: hipFuncSetAttribute failed\n"); grid = -1; return grid; }
        if (hipOccupancyMaxActiveBlocksPerMultiprocessor(&per_cu, (const void*)mk_fwd, NTHR, LDS_BYTES) != hipSuccess || per_cu < 1) { fprintf(stderr, "kernel_launch: occupancy query reports %d blocks per CU\n", per_cu); grid = -1; return grid; }
        (void)hipGetLastError();
        grid = cus;
    }
    return grid;
}
static void mk_launch(void* const* d_in, void* d_out, void* d_ws, hipStream_t stream, int nlaunch) {
    const int grid = mk_grid(); if (grid <= 0) return;
    (void)hipMemsetAsync((char*)d_ws + WS_CTL, 0, CTL_ZERO_BYTES, stream);
    Args a{};
    for (int i = 0; i < 29; ++i) a.in[i] = (const float*)d_in[i];
    a.out = (float*)d_out; a.ws = (unsigned char*)d_ws; a.rep = MK_REP_PHASE;
    if (nlaunch == 1) { a.ph_lo = 0; a.ph_hi = N_PHASES; hipLaunchKernelGGL(mk_fwd, dim3(grid), dim3(NTHR), LDS_BYTES, stream, a); }
    else for (int p = 0; p < N_PHASES; ++p) { a.ph_lo = p; a.ph_hi = p + 1; hipLaunchKernelGGL(mk_fwd, dim3(grid), dim3(NTHR), LDS_BYTES, stream, a); }
}

extern "C" void kernel_launch(void* const* d_in, const int* in_sizes, int n_in, void* d_out, int out_size, void* d_ws, size_t ws_size, hipStream_t stream) {
    if (n_in != 29 || out_size != M * D || ws_size < WS_END) { fprintf(stderr, "kernel_launch: unexpected sizes\n"); return; }
    mk_launch(d_in, d_out, d_ws, stream, MK_N_LAUNCHES);
}
```

```cpp
#define MK_N_LAUNCHES 1
#include <hip/hip_runtime.h>
#include <hip/hip_bf16.h>
#include <cstdio>
#include <cstdint>
#include <cmath>

#define LAS __attribute__((address_space(3)))
#define GAS __attribute__((address_space(1)))
typedef unsigned short bf16_t;
typedef short bf16x8 __attribute__((ext_vector_type(8)));
typedef float f32x4 __attribute__((ext_vector_type(4)));
typedef float f32x2 __attribute__((ext_vector_type(2)));
typedef float f32x16 __attribute__((ext_vector_type(16)));
typedef unsigned u32x4 __attribute__((ext_vector_type(4)));
typedef unsigned u32x2 __attribute__((ext_vector_type(2)));
typedef short s16x4 __attribute__((ext_vector_type(4)));

constexpr int NB = 8, SEQ = 2048, D = 1024, M = NB * SEQ, NMEM = 256, MROWS = NB * NMEM;
constexpr int TOK = 768, MEMW = 256, DFF = 2816, NFOX = 12, ZW = 1792, KVW = 768;
constexpr float EPS = 1e-6f;
constexpr float LOG2E = 1.4426950408889634f;
constexpr float C2 = 0.125f * LOG2E;
constexpr int NWAVES = 8, NTHR = 512;

constexpr size_t MiB = 1u << 20;
constexpr size_t WS_CTL = 0, CTL_ZERO_BYTES = 64 * 1024;
constexpr size_t WS_WIN = 1 * MiB;
constexpr size_t WS_WMEM = 5 * MiB;
constexpr size_t WS_AWOUT = 7 * MiB;
constexpr size_t WS_AFFI = 9 * MiB;
constexpr size_t WS_AFFO = 20 * MiB;
constexpr size_t WS_KVQ = 26 * MiB;
constexpr size_t WS_BWOUT = 32 * MiB;
constexpr size_t WS_BFFI = 34 * MiB;
constexpr size_t WS_BFFO = 45 * MiB;
constexpr size_t WS_XB = 51 * MiB;
constexpr size_t WS_MIX = 83 * MiB;
constexpr size_t WS_MEMB = 115 * MiB;
constexpr size_t WS_MEMKV = 119 * MiB;
constexpr size_t WS_SS4 = 123 * MiB;
constexpr size_t WS_MEMSS = 123 * MiB + 256 * 1024;
constexpr size_t WS_VSSP = 123 * MiB + 512 * 1024;
constexpr size_t WS_LF = 124 * MiB + 512 * 1024;
constexpr size_t WS_HALO = 126 * MiB;
constexpr size_t WS_R1 = 137 * MiB;
constexpr size_t WS_KB = WS_R1, WS_VB = WS_R1 + 24 * MiB, WS_QB = WS_R1 + 48 * MiB;
constexpr size_t WS_QMEM = 225 * MiB;
constexpr size_t WS_END = 233 * MiB;

constexpr int RING_BYTES = 131072;
constexpr int MISC_OFF = RING_BYTES;
constexpr int LDS_BYTES = 147456;

#define RLX_AGENT __ATOMIC_RELAXED, __HIP_MEMORY_SCOPE_AGENT
__device__ __forceinline__ unsigned f2bf(float f) { unsigned u = __builtin_bit_cast(unsigned, f); return (u + 0x7fffu + ((u >> 16) & 1u)) >> 16; }
__device__ __forceinline__ unsigned pk2(float lo, float hi) {
    typedef __bf16 bf2 __attribute__((ext_vector_type(2)));
    f32x2 v = {lo, hi}; bf2 b = __builtin_convertvector(v, bf2); return __builtin_bit_cast(unsigned, b); }
__device__ __forceinline__ float bf_lo(unsigned u) { return __builtin_bit_cast(float, u << 16); }
__device__ __forceinline__ float bf_hi(unsigned u) { return __builtin_bit_cast(float, u & 0xffff0000u); }
__device__ __forceinline__ float wave_sum(float v) {
#pragma unroll
    for (int o = 1; o < 64; o <<= 1) v += __shfl_xor(v, o);
    return v;
}
__device__ __forceinline__ float gelu_tanh(float x) {
    const float u = x * (0.7978845608028654f + 0.035677408136300125f * x * x);
    return x * __builtin_amdgcn_rcpf(1.0f + __builtin_amdgcn_exp2f(-2.0f * LOG2E * u));
}
__device__ __forceinline__ float silu_f(float x) { return x * __builtin_amdgcn_rcpf(1.0f + __builtin_amdgcn_exp2f(-LOG2E * x)); }
__device__ __forceinline__ float log_sigmoid_f(float x) { return x >= 0.f ? -log1pf(__expf(-x)) : x - log1pf(__expf(x)); }

#define XB_TMO      128
#define XB_XCNT(j)  (256  + 64 * (j))
#define XB_XSUB(j)  (1280 + 64 * (j))
#define XB_XGEN(j)  (2304 + 64 * (j))
#define XB_TOP      3328
#define XB_TOPGEN   3392
#define XCD_BAR_WORDS 3456
#define XB_SPIN_CAP (1u << 18)
__device__ __forceinline__ unsigned xb_ld(unsigned* p)              { return __hip_atomic_load(p, __ATOMIC_RELAXED, __HIP_MEMORY_SCOPE_AGENT); }
__device__ __forceinline__ unsigned xb_add(unsigned* p, unsigned v) { return __hip_atomic_fetch_add(p, v, __ATOMIC_RELAXED, __HIP_MEMORY_SCOPE_AGENT); }
__device__ __forceinline__ unsigned xb_xcc_id() { return (unsigned)__builtin_amdgcn_s_getreg((3 << 11) | 20) & 0xFu; }
#define XB_SPIN(cond, bar) do { unsigned _sp = 0; while (cond) { __builtin_amdgcn_s_sleep(1); \
    if ((++_sp & 255u) == 0u) { if (xb_ld(&(bar)[XB_TMO])) break; if (_sp > XB_SPIN_CAP) { atomicAdd(&(bar)[XB_TMO], 1u); break; } } } } while (0)
struct XcdBarrier { unsigned* bar; unsigned x; volatile LAS unsigned* st; };
__device__ __forceinline__ XcdBarrier xcd_barrier_post(unsigned* bar, volatile LAS unsigned* st) {
    XcdBarrier b; b.bar = bar; b.x = xb_xcc_id(); b.st = st;
    if (threadIdx.x == 0) (void)xb_add(&bar[XB_XCNT(b.x)], 1u);
    return b;
}
__device__ __forceinline__ void xcd_barrier_complete(unsigned* bar, unsigned x, unsigned& nloc, unsigned& nx) {
    const unsigned G = gridDim.x * gridDim.y * gridDim.z;
    unsigned sum, cnt, mine, sp = 0u;
    for (;;) {
        sum = 0u; cnt = 0u; mine = 0u;
#pragma unroll
        for (unsigned j = 0; j < 16; ++j) { const unsigned c = xb_ld(&bar[XB_XCNT(j)]); sum += c; cnt += (c > 0u) ? 1u : 0u; mine = (j == x) ? c : mine; }
        if (sum == G) break;
        __builtin_amdgcn_s_sleep(1);
        if ((++sp & 255u) == 0u) { if (xb_ld(&bar[XB_TMO])) break; if (sp > XB_SPIN_CAP) { atomicAdd(&bar[XB_TMO], 1u); break; } }
    }
    nloc = mine > 0u ? mine : 1u; nx = cnt > 0u ? cnt : 1u;
}
__device__ __forceinline__ void xcd_barrier(const XcdBarrier& b) {
    asm volatile("s_waitcnt vmcnt(0)" ::: "memory");
    __syncthreads();
    if (threadIdx.x == 0) {
        unsigned* bar = b.bar;
        __builtin_amdgcn_s_waitcnt(0);
        unsigned nloc = b.st[0], nx = b.st[1];
        if (nloc == 0u) { xcd_barrier_complete(bar, b.x, nloc, nx); b.st[0] = nloc; b.st[1] = nx; }
        const unsigned old = xb_add(&bar[XB_XSUB(b.x)], 1u);
        const unsigned gen = old / nloc;
        if (old + 1u == (gen + 1u) * nloc) {
            __builtin_amdgcn_fence(__ATOMIC_RELEASE, "agent");
            asm volatile("s_waitcnt vmcnt(0)" ::: "memory");
            const unsigned og = xb_add(&bar[XB_TOP], 1u);
            const unsigned tg = og / nx;
            if (og + 1u == (tg + 1u) * nx) xb_add(&bar[XB_TOPGEN], 1u);
            else XB_SPIN(xb_ld(&bar[XB_TOPGEN]) == tg, bar);
            __builtin_amdgcn_fence(__ATOMIC_ACQUIRE, "agent");
            xb_add(&bar[XB_XGEN(b.x)], 1u);
            asm volatile("s_waitcnt vmcnt(0)" ::: "memory");
        } else {
            XB_SPIN(xb_ld(&bar[XB_XGEN(b.x)]) == gen, bar);
            __builtin_amdgcn_fence(__ATOMIC_ACQUIRE, "agent");
            asm volatile("s_waitcnt vmcnt(0)" ::: "memory");
        }
    }
    __syncthreads();
}

namespace pg8 {
constexpr int BM = 256, BK = 64, HALF = 128, HTB = HALF * BK * 2, STAGE_BYTES = 8 * HTB, NXCD = 8, WGM = 8;
__host__ __device__ __forceinline__ int lds_byte(int r, int c) { const int st = (r >> 4) * 2 + (c >> 5), rr = r & 15, cc = c & 31, ob = rr * 64 + cc * 2; return st * 1024 + (ob ^ (((ob >> 9) & 1) << 5)); }
__host__ __device__ __forceinline__ void stage_rc(int b, int& R, int& C) { const int st = b / 1024, sb = b % 1024, swz = sb ^ (((sb >> 9) & 1) << 5); R = (st >> 1) * 16 + swz / 64; C = (st & 1) * 32 + (swz % 64) / 2; }
__host__ __device__ __forceinline__ int perm32(int rho) { const int n = rho >> 4, i = rho & 15; return 8 * (i >> 2) + 4 * n + (i & 3); }

struct Unit { int pm, pn, kind; };
struct Sched {
    int nM, nN, nwg, G, c, K; const bf16_t* A; const bf16_t* Bt;
    int nwg2, nM2; const bf16_t* A2; const bf16_t* Bt2;
    __device__ __forceinline__ void init(int M_, int N_, int K_, int G_, int c_, const bf16_t* A_, const bf16_t* Bt_) { nM = M_ / BM; nN = N_ / BM; nwg = nM * nN; G = G_; c = c_; K = K_; A = A_; Bt = Bt_; nwg2 = 0; nM2 = 1; A2 = A_; Bt2 = Bt_; }
    __device__ __forceinline__ void extra(int M2, int N2, const bf16_t* A2_, const bf16_t* Bt2_) { nM2 = M2 / BM; nwg2 = nM2 * (N2 / BM); A2 = A2_; Bt2 = Bt2_; }
    __device__ __forceinline__ bool next(int i, Unit& u) const {
        const long L = (long)i * G + c;
        if (L >= nwg) { const long e = L - nwg; if (e >= nwg2) return false; u.pm = (int)(e % nM2); u.pn = (int)(e / nM2); u.kind = 1; return true; }
        int wgid = (int)L; { const int q = nwg / NXCD, r = nwg % NXCD, xcd = wgid % NXCD, off = wgid / NXCD; wgid = (xcd < r ? xcd * (q + 1) : r * (q + 1) + (xcd - r) * q) + off; }
        const int nig = WGM * nN, gid = wgid / nig, fm = gid * WGM, gsz = (nM - fm) < WGM ? (nM - fm) : WGM;
        u.pm = fm + ((wgid % nig) % gsz); u.pn = (wgid % nig) / gsz; u.kind = 0; return true;
    }
    __device__ __forceinline__ const char* a_ptr(const Unit& u) const { return (const char*)(u.kind ? A2 : A) + (size_t)u.pm * BM * K * 2; }
    __device__ __forceinline__ const char* b_ptr(const Unit& u) const { return (const char*)(u.kind ? Bt2 : Bt) + (size_t)u.pn * BM * K * 2; }
};

template <class Epi, bool ALIGN_EPI, bool A_PERM>
__device__ __forceinline__ void gemm_phase(LAS unsigned char* lds, const Sched& S, const Epi& E) {
    int tid = threadIdx.x; asm volatile("" : "+v"(tid));
    const int wid = __builtin_amdgcn_readfirstlane(tid >> 6), lane = tid & 63, wr = wid >> 2, wc = wid & 3, fr = lane & 15, fq = lane >> 4;
    const int K = S.K, nt = K / BK;
    unsigned voffA[2], voffB[2];
#pragma unroll
    for (int i = 0; i < 2; ++i) { int R, C; stage_rc(tid * 16 + i * 8192, R, C); const int Rb = (R & ~31) + perm32(R & 31);
        const int Ra = A_PERM ? (128 * (R >> 6) + 8 * (R & 15) + ((R >> 4) & 3)) : R;
        voffA[i] = (unsigned)(Ra * K + C) * 2u; voffB[i] = (unsigned)(Rb * K + C) * 2u; }
    const size_t kstep = (size_t)(BK * 2);
    const size_t hstepB = (size_t)HALF * K * 2;
    const size_t hstepA = A_PERM ? (size_t)4 * K * 2 : (size_t)HALF * K * 2;
    const unsigned ldsw = (unsigned)wid * 1024u;
    const int aoff = lds_byte(wr * 64 + fr, fq * 8), boff = lds_byte(wc * 32 + fr, fq * 8);
#define PG8_SA(b, h) (((b) * 2 + (h)) * HTB)
#define PG8_SB(b, h) ((4 + (b) * 2 + (h)) * HTB)
#define PG8_STAGE(bufoff, gbase, voff) do { _Pragma("unroll") for (int _i = 0; _i < 2; ++_i) \
        __builtin_amdgcn_global_load_lds((const unsigned*)((const char*)(gbase) + (voff)[_i]), (LAS unsigned*)(lds + (bufoff) + ldsw + _i * 8192), 16, 0, 0); } while (0)
#define PG8_LDA(dst, b, h) do { _Pragma("unroll") for (int m = 0; m < 4; ++m) _Pragma("unroll") for (int k = 0; k < 2; ++k) dst[m][k] = *(const LAS bf16x8*)(lds + PG8_SA(b, h) + aoff + m * 2048 + k * 1024); } while (0)
#define PG8_LDB(dst, b, h) do { _Pragma("unroll") for (int n = 0; n < 2; ++n) _Pragma("unroll") for (int k = 0; k < 2; ++k) dst[n][k] = *(const LAS bf16x8*)(lds + PG8_SB(b, h) + boff + n * 2048 + k * 1024); } while (0)
#define PG8_MMA(ai, bj, At, Bt) do { __builtin_amdgcn_s_setprio(1); _Pragma("unroll") for (int m = 0; m < 4; ++m) _Pragma("unroll") for (int n = 0; n < 2; ++n) _Pragma("unroll") for (int k = 0; k < 2; ++k) \
        acc[ai][bj][m][n] = __builtin_amdgcn_mfma_f32_16x16x32_bf16(Bt[n][k], At[m][k], acc[ai][bj][m][n], 0, 0, 0); __builtin_amdgcn_s_setprio(0); } while (0)
#define PG8_WAIT_V(n) asm volatile("s_waitcnt vmcnt(" #n ")" ::: "memory")
#define PG8_WAIT_L(n) asm volatile("s_waitcnt lgkmcnt(" #n ")" ::: "memory")
#define PG8_BAR __builtin_amdgcn_s_barrier()
#define PG8_SCHED __builtin_amdgcn_sched_barrier(0)
    Unit cur, nxt; int ui = 0;
    if (!S.next(0, cur)) return;
    f32x4 acc[2][2][4][2];
#pragma unroll
    for (int a = 0; a < 2; ++a)
#pragma unroll
        for (int b = 0; b < 2; ++b)
#pragma unroll
            for (int m = 0; m < 4; ++m)
#pragma unroll
                for (int n = 0; n < 2; ++n) acc[a][b][m][n] = (f32x4){0.f, 0.f, 0.f, 0.f};
    bf16x8 At[4][2], B0[2][2], B1[2][2];
    const char* cA = S.a_ptr(cur); const char* cB = S.b_ptr(cur);
    PG8_STAGE(PG8_SB(0, 0), cB, voffB); PG8_STAGE(PG8_SB(0, 1), cB + hstepB, voffB); PG8_STAGE(PG8_SA(0, 0), cA, voffA); PG8_STAGE(PG8_SA(0, 1), cA + hstepA, voffA);
    if (wr == 1) PG8_BAR;
    PG8_WAIT_V(2); PG8_BAR;
    PG8_STAGE(PG8_SB(1, 0), cB + kstep, voffB); PG8_STAGE(PG8_SA(1, 0), cA + kstep, voffA); PG8_STAGE(PG8_SB(1, 1), cB + hstepB + kstep, voffB);
    PG8_WAIT_V(6); PG8_BAR;
    for (;;) {
        const bool has_next = S.next(ui + 1, nxt);
        const char* nA = has_next ? S.a_ptr(nxt) : cA; const char* nB = has_next ? S.b_ptr(nxt) : cB;
        for (int t = 0; t < nt; t += 2) {
            const bool last = (t == nt - 2);
            const char* a1 = cA + (size_t)(t + 1) * kstep;
            const char* a2 = last ? nA : cA + (size_t)(t + 2) * kstep; const char* b2 = last ? nB : cB + (size_t)(t + 2) * kstep;
            const char* a3 = a2 + kstep; const char* b3 = b2 + kstep;
            PG8_LDB(B0, 0, 0); PG8_LDB(B1, 0, 1); PG8_SCHED; PG8_LDA(At, 0, 0); PG8_STAGE(PG8_SA(1, 1), a1 + hstepA, voffA);
            PG8_WAIT_V(8); PG8_WAIT_L(0); PG8_BAR; PG8_MMA(0, 0, At, B0); PG8_MMA(0, 1, At, B1); PG8_BAR; PG8_SCHED;
            PG8_LDA(At, 0, 1); PG8_STAGE(PG8_SB(0, 0), b2, voffB); PG8_STAGE(PG8_SB(0, 1), b2 + hstepB, voffB); PG8_STAGE(PG8_SA(0, 0), a2, voffA);
            PG8_WAIT_V(8); PG8_WAIT_L(0); PG8_BAR; PG8_MMA(1, 0, At, B0); PG8_MMA(1, 1, At, B1); PG8_BAR; PG8_SCHED;
            PG8_LDB(B0, 1, 0); PG8_LDB(B1, 1, 1); PG8_SCHED; PG8_LDA(At, 1, 0); PG8_STAGE(PG8_SA(0, 1), a2 + hstepA, voffA);
            PG8_WAIT_V(8); PG8_WAIT_L(0); PG8_BAR; PG8_MMA(0, 0, At, B0); PG8_MMA(0, 1, At, B1); PG8_BAR; PG8_SCHED;
            PG8_LDA(At, 1, 1); PG8_STAGE(PG8_SB(1, 0), b3, voffB); PG8_STAGE(PG8_SB(1, 1), b3 + hstepB, voffB); PG8_STAGE(PG8_SA(1, 0), a3, voffA);
            PG8_WAIT_V(8); PG8_WAIT_L(0); PG8_BAR; PG8_MMA(1, 0, At, B0); PG8_MMA(1, 1, At, B1); PG8_BAR; PG8_SCHED;
        }
        if constexpr (ALIGN_EPI) { if (wr == 0) PG8_BAR; }
        if constexpr (!Epi::AFTER_DRAIN) { E(acc, cur, wr, wc, fr, fq); }
        if (!has_next) break;
#pragma unroll
        for (int a = 0; a < 2; ++a)
#pragma unroll
            for (int b = 0; b < 2; ++b)
#pragma unroll
                for (int m = 0; m < 4; ++m)
#pragma unroll
                    for (int n = 0; n < 2; ++n) acc[a][b][m][n] = (f32x4){0.f, 0.f, 0.f, 0.f};
        cur = nxt; cA = nA; cB = nB; ++ui;
        if constexpr (ALIGN_EPI) { if (wr == 1) PG8_BAR; }
    }
    PG8_WAIT_V(0);
    if constexpr (!ALIGN_EPI) { if (wr == 0) PG8_BAR; }
    PG8_BAR;
    if constexpr (Epi::AFTER_DRAIN) { E.fused(acc, cur, wr, wc, fr, fq, lds, wid, lane); }
#undef PG8_SA
#undef PG8_SB
#undef PG8_STAGE
#undef PG8_LDA
#undef PG8_LDB
#undef PG8_MMA
#undef PG8_WAIT_V
#undef PG8_WAIT_L
#undef PG8_BAR
#undef PG8_SCHED
}
}

namespace pg8 {
__device__ __forceinline__ float rstd_of(const float* ss4, int row) { const f32x4 s = *(const f32x4*)(ss4 + (size_t)row * 4); return rsqrtf(((s[0] + s[1]) + (s[2] + s[3])) * (1.0f / D) + EPS); }

struct EpiIn {
    static constexpr bool AFTER_DRAIN = false;
    bf16_t* z; bf16_t* memkv; bf16_t* qmem; const float* ss4; const float* memss; float* vssp;
    __device__ __forceinline__ void operator()(const f32x4 (&acc)[2][2][4][2], const Unit& u, int wr, int wc, int fr, int fq) const {
        const bool main = (u.kind == 0), act = main && (u.pn < 6), vt = main && (u.pn >= 3) && (u.pn < 6);
        bf16_t* obase = main ? z : memkv; int ldc = main ? ZW : 1024;
        int col0 = u.pn * BM + wc * 32 + 8 * fq;
        if (main && u.pn == 6) { obase = qmem; ldc = MEMW; col0 -= 6 * BM; }
        const float* ssb = main ? ss4 : memss;
        float rsv[8];
#pragma unroll
        for (int j = 0; j < 8; ++j) rsv[j] = rstd_of(ssb, u.pm * BM + (j >> 2) * HALF + wr * 64 + (j & 3) * 16 + fr);
#pragma unroll
        for (int ai = 0; ai < 2; ++ai)
#pragma unroll
            for (int m = 0; m < 4; ++m) {
                const int row = u.pm * BM + ai * HALF + wr * 64 + m * 16 + fr;
                const float rs = rsv[ai * 4 + m];
                float sq = 0.f;
#pragma unroll
                for (int bj = 0; bj < 2; ++bj) {
                    f32x4 v0 = acc[ai][bj][m][0] * rs, v1 = acc[ai][bj][m][1] * rs;
                    if (act) {
#pragma unroll
                        for (int e = 0; e < 4; ++e) { v0[e] = gelu_tanh(v0[e]); v1[e] = gelu_tanh(v1[e]); }
                    }
                    sq += (v0[0] * v0[0] + v0[1] * v0[1]) + (v0[2] * v0[2] + v0[3] * v0[3]) + (v1[0] * v1[0] + v1[1] * v1[1]) + (v1[2] * v1[2] + v1[3] * v1[3]);
                    u32x4 w; w.x = pk2(v0[0], v0[1]); w.y = pk2(v0[2], v0[3]); w.z = pk2(v1[0], v1[1]); w.w = pk2(v1[2], v1[3]);
                    *(u32x4*)(obase + (size_t)row * ldc + col0 + bj * HALF) = w;
                }
                if (vt) { sq += __shfl_xor(sq, 16); sq += __shfl_xor(sq, 32); if (fq == 0) vssp[(size_t)row * 12 + (u.pn - 3) * 4 + wc] = sq; }
            }
    }
};

struct EpiKvq {
    static constexpr bool AFTER_DRAIN = false;
    bf16_t* kb; bf16_t* vb; bf16_t* qb; bf16_t* qmem; float* lf; const float* ss4; const float* b_f;
    __device__ __forceinline__ void operator()(const f32x4 (&acc)[2][2][4][2], const Unit& u, int wr, int wc, int fr, int fq) const {
        bf16_t* obase; int ldc, colt;
        if (u.pn < 3) { obase = kb; ldc = KVW; colt = u.pn * BM; } else if (u.pn < 6) { obase = vb; ldc = KVW; colt = (u.pn - 3) * BM; } else if (u.pn < 9) { obase = qb; ldc = KVW; colt = (u.pn - 6) * BM; } else { obase = qmem; ldc = MEMW; colt = 0; }
        const int col0 = colt + wc * 32 + 8 * fq;
        const bool ftile = (u.pn == 10);
        float rsv[8];
#pragma unroll
        for (int j = 0; j < 8; ++j) rsv[j] = rstd_of(ss4, u.pm * BM + (j >> 2) * HALF + wr * 64 + (j & 3) * 16 + fr);
#pragma unroll
        for (int ai = 0; ai < 2; ++ai)
#pragma unroll
            for (int m = 0; m < 4; ++m) {
                const int row = u.pm * BM + ai * HALF + wr * 64 + m * 16 + fr;
                const float rs = rsv[ai * 4 + m];
                if (!ftile) {
#pragma unroll
                    for (int bj = 0; bj < 2; ++bj) {
                        const f32x4 v0 = acc[ai][bj][m][0] * rs, v1 = acc[ai][bj][m][1] * rs;
                        u32x4 w; w.x = pk2(v0[0], v0[1]); w.y = pk2(v0[2], v0[3]); w.z = pk2(v1[0], v1[1]); w.w = pk2(v1[2], v1[3]);
                        *(u32x4*)(obase + (size_t)row * ldc + col0 + bj * HALF) = w;
                    }
                } else if (wc == 0 && fq < 2) {
                    const int b = row / SEQ, t = row % SEQ;
#pragma unroll
                    for (int n = 0; n < 2; ++n)
#pragma unroll
                        for (int e = 0; e < 4; ++e) { const int h = 8 * fq + 4 * n + e; if (h < NFOX) lf[((size_t)b * NFOX + h) * SEQ + t] = log_sigmoid_f(acc[ai][0][m][n][e] * rs + b_f[h]); }
                }
            }
    }
};

template <bool R_F32, bool OUT_F32>
struct EpiRes {
    static constexpr bool AFTER_DRAIN = true;
    const float* R; float* xf; bf16_t* xb; float* ss4;
    __device__ __forceinline__ void fused(f32x4 (&acc)[2][2][4][2], const Unit& u, int wr, int wc, int fr, int fq, LAS unsigned char* lds, int wid, int lane) const {
        LAS float* P = (LAS float*)lds;
        const int col0 = u.pn * BM + wc * 32 + 8 * fq;
        if constexpr (!R_F32) {
            u32x4 rb[2][4][2];
#pragma unroll
            for (int ai = 0; ai < 2; ++ai)
#pragma unroll
                for (int m = 0; m < 4; ++m)
#pragma unroll
                    for (int bj = 0; bj < 2; ++bj) rb[ai][m][bj] = *(const u32x4*)(xb + (size_t)(u.pm * BM + ai * HALF + wr * 64 + m * 16 + fr) * D + col0 + bj * HALF);
#pragma unroll
            for (int ai = 0; ai < 2; ++ai)
#pragma unroll
                for (int m = 0; m < 4; ++m)
#pragma unroll
                    for (int bj = 0; bj < 2; ++bj) { const u32x4 w = rb[ai][m][bj];
                        acc[ai][bj][m][0] += (f32x4){bf_lo(w.x), bf_hi(w.x), bf_lo(w.y), bf_hi(w.y)}; acc[ai][bj][m][1] += (f32x4){bf_lo(w.z), bf_hi(w.z), bf_lo(w.w), bf_hi(w.w)}; }
        } else {
#pragma unroll
            for (int ai = 0; ai < 2; ++ai) {
                f32x4 rf[4][2][2];
#pragma unroll
                for (int m = 0; m < 4; ++m)
#pragma unroll
                    for (int bj = 0; bj < 2; ++bj) { const float* rp = R + (size_t)(u.pm * BM + ai * HALF + wr * 64 + m * 16 + fr) * D + col0 + bj * HALF; rf[m][bj][0] = *(const f32x4*)rp; rf[m][bj][1] = *(const f32x4*)(rp + 4); }
#pragma unroll
                for (int m = 0; m < 4; ++m)
#pragma unroll
                    for (int bj = 0; bj < 2; ++bj) { acc[ai][bj][m][0] += rf[m][bj][0]; acc[ai][bj][m][1] += rf[m][bj][1]; }
            }
        }
#pragma unroll
        for (int ai = 0; ai < 2; ++ai)
#pragma unroll
            for (int m = 0; m < 4; ++m) {
                const int rl = ai * HALF + wr * 64 + m * 16 + fr; const size_t off = (size_t)(u.pm * BM + rl) * D + col0;
                float sq = 0.f;
#pragma unroll
                for (int bj = 0; bj < 2; ++bj) {
                    const f32x4 v0 = acc[ai][bj][m][0], v1 = acc[ai][bj][m][1];
                    if constexpr (OUT_F32) { *(f32x4*)(xf + off + bj * HALF) = v0; *(f32x4*)(xf + off + bj * HALF + 4) = v1; }
                    else { u32x4 w; w.x = pk2(v0[0], v0[1]); w.y = pk2(v0[2], v0[3]); w.z = pk2(v1[0], v1[1]); w.w = pk2(v1[2], v1[3]); *(u32x4*)(xb + off + bj * HALF) = w; }
                    sq += (v0[0] * v0[0] + v0[1] * v0[1]) + (v0[2] * v0[2] + v0[3] * v0[3]) + (v1[0] * v1[0] + v1[1] * v1[1]) + (v1[2] * v1[2] + v1[3] * v1[3]);
                }
                sq += __shfl_xor(sq, 16); sq += __shfl_xor(sq, 32);
                if (fq == 0) P[rl * 4 + wc] = sq;
            }
        __syncthreads();
        if (threadIdx.x < 256) { const int rl = threadIdx.x; const f32x4 p = *(const LAS f32x4*)(P + rl * 4); ss4[(size_t)(u.pm * BM + rl) * 4 + u.pn] = (p[0] + p[1]) + (p[2] + p[3]); }
        __syncthreads();
    }
};

__device__ __forceinline__ float dpp_shr1_f(float x) {
    int xi = __builtin_bit_cast(int, x);
    asm volatile("" : "+v"(xi));
    return __builtin_bit_cast(float, __builtin_amdgcn_update_dpp(0, xi, 0x111, 0xf, 0xf, true));
}
__device__ __forceinline__ f32x4 dpp_shr1(f32x4 v) { f32x4 r; r[0] = dpp_shr1_f(v[0]); r[1] = dpp_shr1_f(v[1]); r[2] = dpp_shr1_f(v[2]); r[3] = dpp_shr1_f(v[3]); return r; }
struct EpiFfn {
    static constexpr bool AFTER_DRAIN = false;
    bf16_t* g; float* halo; const float* ss4; const float* cw; const float* cb;
    __device__ __forceinline__ void operator()(f32x4 (&acc)[2][2][4][2], const Unit& u, int wr, int wc, int fr, int fq) const {
        const int T0 = u.pm * BM + wr * 128 + fr * 8;
        float rsv[8];
#pragma unroll
        for (int j = 0; j < 8; ++j) rsv[j] = rstd_of(ss4, T0 + j);
#pragma unroll
        for (int j = 0; j < 8; ++j) { const float r = rsv[j];
#pragma unroll
            for (int bj = 0; bj < 2; ++bj)
#pragma unroll
                for (int n = 0; n < 2; ++n) acc[j >> 2][bj][j & 3][n] *= r; }
        const int jc0 = u.pn * 128 + wc * 32 + 8 * fq;
        const int run = u.pm * 2 + wr;
        float* hrun = halo + (size_t)run * 4 * 5632 + u.pn * BM + wc * 32 + 8 * fq;
        unsigned pk[2][8][2];
#pragma unroll
        for (int n = 0; n < 2; ++n) {
            if (fr == 0) { *(f32x4*)(hrun + 4 * n) = acc[0][0][0][n]; *(f32x4*)(hrun + 5632 + 4 * n) = acc[0][0][1][n]; *(f32x4*)(hrun + HALF + 4 * n) = acc[0][1][0][n]; *(f32x4*)(hrun + 5632 + HALF + 4 * n) = acc[0][1][1][n]; }
            if (fr == 15) { *(f32x4*)(hrun + 2 * 5632 + 4 * n) = acc[1][0][2][n]; *(f32x4*)(hrun + 3 * 5632 + 4 * n) = acc[1][0][3][n]; *(f32x4*)(hrun + 2 * 5632 + HALF + 4 * n) = acc[1][1][2][n]; *(f32x4*)(hrun + 3 * 5632 + HALF + 4 * n) = acc[1][1][3][n]; }
        }
#pragma unroll
        for (int n = 0; n < 2; ++n) {
            const int cg = jc0 + 4 * n, cu = DFF + cg;
#pragma unroll
            for (int bj = 0; bj < 2; ++bj) {
                const int cc = bj ? cu : cg;
                const f32x4 w0 = *(const f32x4*)(cw + cc), w1 = *(const f32x4*)(cw + 5632 + cc), w2 = *(const f32x4*)(cw + 2 * 5632 + cc), bb = *(const f32x4*)(cb + cc);
                const f32x4 p1 = dpp_shr1(acc[1][bj][3][n]), p2 = dpp_shr1(acc[1][bj][2][n]);
#pragma unroll
                for (int j = 7; j >= 0; --j) {
                    const f32x4 h1 = j >= 1 ? acc[(j >= 1 ? j - 1 : 0) >> 2][bj][(j >= 1 ? j - 1 : 0) & 3][n] : p1;
                    const f32x4 h2 = j >= 2 ? acc[(j >= 2 ? j - 2 : 0) >> 2][bj][(j >= 2 ? j - 2 : 0) & 3][n] : (j == 1 ? p1 : p2);
                    acc[j >> 2][bj][j & 3][n] = bb + w2 * acc[j >> 2][bj][j & 3][n] + w1 * h1 + w0 * h2;
                }
            }
#pragma unroll
            for (int j = 0; j < 8; ++j) {
                const f32x4 cgv = acc[j >> 2][0][j & 3][n], cuv = acc[j >> 2][1][j & 3][n];
                f32x4 o;
#pragma unroll
                for (int e = 0; e < 4; ++e) o[e] = silu_f(cgv[e]) * cuv[e];
                pk[n][j][0] = pk2(o[0], o[1]); pk[n][j][1] = pk2(o[2], o[3]);
            }
        }
#pragma unroll
        for (int j = 0; j < 8; ++j) {
            u32x4 w; w.x = pk[0][j][0]; w.y = pk[0][j][1]; w.z = pk[1][j][0]; w.w = pk[1][j][1];
            *(u32x4*)(g + (size_t)(T0 + j) * DFF + jc0) = w;
        }
    }
};
}

__device__ __forceinline__ void fixup_panel(int pm, bf16_t* g, const float* halo, const float* cw, const float* cb) {
    for (int it = threadIdx.x; it < 4 * 704; it += NTHR) {
        const int rj = it / 704, grp = it % 704, run = 2 * pm + (rj >> 1), j = rj & 1;
        if ((run & 15) == 0) continue;
        const int col = grp * 4, q = col >> 7, i = col & 127, ng = q * 256 + i;
        const float* hc = halo + (size_t)run * 4 * 5632; const float* hp = halo + (size_t)(run - 1) * 4 * 5632;
        f32x4 r[2];
#pragma unroll
        for (int p = 0; p < 2; ++p) {
            const int nn = ng + 128 * p, cc = col + DFF * p;
            const f32x4 h0 = *(const f32x4*)(hc + nn), h1 = *(const f32x4*)(hc + 5632 + nn), p2 = *(const f32x4*)(hp + 2 * 5632 + nn), p3 = *(const f32x4*)(hp + 3 * 5632 + nn);
            const f32x4 w0 = *(const f32x4*)(cw + cc), w1 = *(const f32x4*)(cw + 5632 + cc), w2 = *(const f32x4*)(cw + 2 * 5632 + cc), bb = *(const f32x4*)(cb + cc);
            r[p] = (j == 0) ? (bb + w2 * h0 + w1 * p3 + w0 * p2) : (bb + w2 * h1 + w1 * h0 + w0 * p3);
        }
        u32x2 w; w.x = pk2(silu_f(r[0][0]) * r[1][0], silu_f(r[0][1]) * r[1][1]); w.y = pk2(silu_f(r[0][2]) * r[1][2], silu_f(r[0][3]) * r[1][3]);
        *(u32x2*)(g + (size_t)(run * 128 + j) * DFF + col) = w;
    }
    asm volatile("s_waitcnt vmcnt(0)" ::: "memory");
    __syncthreads();
}

__device__ __forceinline__ void final_phase(int vcu, int G, int wave, int lane, float* xf, const float* ss4, const float* gain) {
    const int gw = vcu * NWAVES + wave, NGW = G * NWAVES;
    f32x4 gv[4];
#pragma unroll
    for (int j = 0; j < 4; ++j) gv[j] = *(const f32x4*)(gain + 4 * lane + 256 * j);
    for (int m = gw; m < M; m += NGW) {
        const float rs = pg8::rstd_of(ss4, m);
        f32x4* xr = (f32x4*)(xf + (size_t)m * D) + lane;
#pragma unroll
        for (int j = 0; j < 4; ++j) { const f32x4 v = xr[64 * j]; xr[64 * j] = v * rs * gv[j]; }
    }
}

struct ItemD { const float* W; const float* gain; bf16_t* dst; int ldw, K, k0, src0, valid, drow0; float scale; };
constexpr int IT_WIN = 16 * 56, IT_WMEM = 16 * 32, IT_WOUT = 16 * 32, IT_FFI = 16 * 176, IT_FFO = 44 * 32, IT_KVQ = 16 * 88;
constexpr int IT0_WIN = 0, IT0_WMEM = IT0_WIN + IT_WIN, IT0_AWOUT = IT0_WMEM + IT_WMEM, IT0_AFFI = IT0_AWOUT + IT_WOUT, IT0_AFFO = IT0_AFFI + IT_FFI, IT0_KVQ = IT0_AFFO + IT_FFO,
              IT0_BWOUT = IT0_KVQ + IT_KVQ, IT0_BFFI = IT0_BWOUT + IT_WOUT, IT0_BFFO = IT0_BFFI + IT_FFI, IT_TOTAL = IT0_BFFO + IT_FFO;
__device__ __forceinline__ ItemD item_desc(int it, const float* const* in, unsigned char* ws) {
    ItemD d; d.scale = 1.f; d.gain = nullptr;
    if (it < IT0_WMEM) { const int r = it - IT0_WIN, nb = r % 56, kb_ = r / 56; d.W = in[3]; d.ldw = ZW; d.K = D; d.k0 = 64 * kb_; d.src0 = 32 * nb; d.valid = ZW; d.gain = in[2]; d.scale = (32 * nb >= 1536) ? C2 : 1.f; d.dst = (bf16_t*)(ws + WS_WIN); d.drow0 = 32 * nb; }
    else if (it < IT0_AWOUT) { const int r = it - IT0_WMEM, nb = r % 32, kb_ = r / 32; const bool lb = nb >= 16; d.W = lb ? in[21] : in[8]; d.ldw = 512; d.K = D; d.k0 = 64 * kb_; d.src0 = 32 * (nb & 15); d.valid = 512; d.gain = lb ? in[20] : in[7]; d.dst = (bf16_t*)(ws + WS_WMEM); d.drow0 = 32 * nb; }
    else if (it < IT0_AFFI) { const int r = it - IT0_AWOUT, nb = r % 32, kb_ = r / 32; d.W = in[9]; d.ldw = D; d.K = D; d.k0 = 64 * kb_; d.src0 = 32 * nb; d.valid = D; d.dst = (bf16_t*)(ws + WS_AWOUT); d.drow0 = 32 * nb; }
    else if (it < IT0_AFFO || (it >= IT0_BFFI && it < IT0_BFFO)) { const bool lb = it >= IT0_BFFI; const int r = it - (lb ? IT0_BFFI : IT0_AFFI), nb = r % 176, kb_ = r / 176; const int n0 = 32 * nb, q = n0 >> 8, i = n0 & 255;
        d.W = lb ? in[24] : in[11]; d.ldw = 5632; d.K = D; d.k0 = 64 * kb_; d.src0 = (i < 128) ? (128 * q + i) : (DFF + 128 * q + (i - 128)); d.valid = 5632; d.gain = lb ? in[23] : in[10]; d.dst = (bf16_t*)(ws + (lb ? WS_BFFI : WS_AFFI)); d.drow0 = n0; }
    else if (it < IT0_KVQ || it >= IT0_BFFO) { const bool lb = it >= IT0_BFFO; const int r = it - (lb ? IT0_BFFO : IT0_AFFO), nb = r % 32, kb_ = r / 32; d.W = lb ? in[27] : in[14]; d.ldw = D; d.K = DFF; d.k0 = 64 * kb_; d.src0 = 32 * nb; d.valid = D; d.dst = (bf16_t*)(ws + (lb ? WS_BFFO : WS_AFFO)); d.drow0 = 32 * nb; }
    else if (it < IT0_BWOUT) { const int r = it - IT0_KVQ, nb = r % 88, kb_ = r / 88; const int n0 = 32 * nb; d.K = D; d.k0 = 64 * kb_; d.dst = (bf16_t*)(ws + WS_KVQ); d.drow0 = n0;
        if (n0 < 1536) { d.W = in[16]; d.ldw = 1548; d.src0 = n0; d.valid = 1548; d.gain = in[15]; }
        else if (n0 < 2560) { d.W = in[19]; d.ldw = D; d.src0 = n0 - 1536; d.valid = D; d.gain = in[18]; d.scale = C2; }
        else { d.W = in[16]; d.ldw = 1548; d.src0 = 1536 + (n0 - 2560); d.valid = (n0 == 2560) ? 1548 : 0; d.gain = in[15]; } }
    else { const int r = it - IT0_BWOUT, nb = r % 32, kb_ = r / 32; d.W = in[22]; d.ldw = D; d.K = D; d.k0 = 64 * kb_; d.src0 = 32 * nb; d.valid = D; d.dst = (bf16_t*)(ws + WS_BWOUT); d.drow0 = 32 * nb; }
    return d;
}
__device__ __forceinline__ void item_load(const ItemD& d, int lane, f32x4 (&v)[8], float (&gv)[8]) {
    const int r = lane >> 3, c4 = 4 * (lane & 7); const bool ok = (d.src0 + c4 + 3) < d.valid;
#pragma unroll
    for (int i = 0; i < 8; ++i) { v[i] = ok ? *(const f32x4*)(d.W + (size_t)(d.k0 + r + 8 * i) * d.ldw + d.src0 + c4) : (f32x4){0.f, 0.f, 0.f, 0.f}; gv[i] = d.gain ? d.gain[d.k0 + r + 8 * i] * d.scale : d.scale; }
}
__device__ __forceinline__ void item_store(const ItemD& d, int lane, const f32x4 (&v)[8], const float (&gv)[8], LAS float* scr) {
    const int r = lane >> 3, c4 = 4 * (lane & 7);
#pragma unroll
    for (int i = 0; i < 8; ++i) { const f32x4 x = v[i] * gv[i]; LAS float* p = scr + (r + 8 * i) * 33 + c4; p[0] = x[0]; p[1] = x[1]; p[2] = x[2]; p[3] = x[3]; }
    asm volatile("s_waitcnt lgkmcnt(0)" ::: "memory");
    const int c = lane & 7;
#pragma unroll
    for (int j = 0; j < 4; ++j) { const int nn = (lane >> 3) + 8 * j; const LAS float* s = scr + (8 * c) * 33 + nn;
        u32x4 o; o.x = pk2(s[0 * 33], s[1 * 33]); o.y = pk2(s[2 * 33], s[3 * 33]); o.z = pk2(s[4 * 33], s[5 * 33]); o.w = pk2(s[6 * 33], s[7 * 33]);
        *(u32x4*)(d.dst + (size_t)(d.drow0 + nn) * d.K + d.k0 + 8 * c) = o; }
    asm volatile("s_waitcnt lgkmcnt(0)" ::: "memory");
}
__device__ __forceinline__ void convert_items(int first, int count, int w, int nw, const float* const* in, unsigned char* ws, LAS float* scr, int lane) {
    int it = first + w; const int end = first + count;
    if (it >= end) return;
    f32x4 va[8], vb[8]; float ga[8], gb_[8];
    ItemD da = item_desc(it, in, ws), db = da;
    item_load(da, lane, va, ga);
    for (;;) {
        const int itb = it + nw; const bool hb = itb < end;
        if (hb) { db = item_desc(itb, in, ws); item_load(db, lane, vb, gb_); }
        item_store(da, lane, va, ga, scr);
        if (!hb) break;
        it = itb + nw; const bool ha = it < end;
        if (ha) { da = item_desc(it, in, ws); item_load(da, lane, va, ga); }
        item_store(db, lane, vb, gb_, scr);
        if (!ha) break;
    }
}
__device__ __forceinline__ void rows2_to_bf16(const float* x0, bf16_t* o0, float* ss0, int lane) {
    f32x4 v[2][4];
#pragma unroll
    for (int r = 0; r < 2; ++r)
#pragma unroll
        for (int j = 0; j < 4; ++j) v[r][j] = ((const f32x4*)(x0 + (size_t)r * D) + lane)[64 * j];
#pragma unroll
    for (int r = 0; r < 2; ++r) { float s = 0.f;
#pragma unroll
        for (int j = 0; j < 4; ++j) { s += (v[r][j][0] * v[r][j][0] + v[r][j][1] * v[r][j][1]) + (v[r][j][2] * v[r][j][2] + v[r][j][3] * v[r][j][3]);
            u32x2 w; w.x = pk2(v[r][j][0], v[r][j][1]); w.y = pk2(v[r][j][2], v[r][j][3]); ((u32x2*)(o0 + (size_t)r * D) + lane)[64 * j] = w; }
        s = wave_sum(s);
        if (lane == 0) *(f32x4*)(ss0 + (size_t)r * 4) = (f32x4){s, 0.f, 0.f, 0.f}; }
}

namespace attn_body {
using bf16 = __hip_bfloat16;
constexpr int NW = 8, QBLK = 32, QB = QBLK * NW, KVBLK = 64;
__device__ __forceinline__ int crow(int r, int hi) { return (r & 3) + 8 * (r >> 2) + 4 * hi; }
#define SBAR() __builtin_amdgcn_sched_barrier(0)
__device__ __forceinline__ void cmask(f32x16& p0, f32x16& p1, int jb, int qrel, int hi) {
    const float NEG = -INFINITY; int kb = 64 * jb + 4 * hi;
#pragma unroll
    for (int r = 0; r < 16; ++r) { int kv = kb + (r & 3) + 8 * (r >> 2); if (kv > qrel) p0[r] = NEG; if (kv + 32 > qrel) p1[r] = NEG; }
}
constexpr int NSLOT = 3, SLOTB = 8192;
constexpr int LDS_K = 0, LDS_V = NSLOT * SLOTB, LDS_WS = 2 * NSLOT * SLOTB, LDS_OST = LDS_WS + NW * 64 * 4, LDS_ATT = LDS_OST + NW * 4096;
constexpr int LDS_BIAS = LDS_ATT, LDS_WTOT = LDS_BIAS + 8192, ATTN_LDS_BYTES = LDS_WTOT + 64;
__device__ __forceinline__ void glds16(const void* gsrc, unsigned lds_dst) { unsigned keep;
    asm volatile("s_mov_b32 %0, m0\n\ts_mov_b32 m0, %2\n\ts_nop 0\n\tglobal_load_lds_dwordx4 %1, off\n\ts_mov_b32 m0, %0" : "=&s"(keep) : "v"(gsrc), "s"(lds_dst) : "memory"); }
#define WAIT_BAR(N) asm volatile("s_waitcnt vmcnt(" #N ") lgkmcnt(0)\n\ts_barrier" ::: "memory")
typedef __attribute__((address_space(3))) const char* lds_cptr;
typedef short v4i16_t __attribute__((ext_vector_type(4)));
__device__ __forceinline__ void kload8(bf16x8* kf, lds_cptr kp) {
    kf[0] = *(const LAS bf16x8*)(kp);        kf[1] = *(const LAS bf16x8*)(kp + 512);
    kf[2] = *(const LAS bf16x8*)(kp + 2048); kf[3] = *(const LAS bf16x8*)(kp + 2560);
    kf[4] = *(const LAS bf16x8*)(kp + 4096); kf[5] = *(const LAS bf16x8*)(kp + 4608);
    kf[6] = *(const LAS bf16x8*)(kp + 6144); kf[7] = *(const LAS bf16x8*)(kp + 6656);
}
__device__ __forceinline__ void kload2(bf16x8* kf, lds_cptr kp, int j) { kf[2 * j] = *(const LAS bf16x8*)(kp + j * 2048); kf[2 * j + 1] = *(const LAS bf16x8*)(kp + j * 2048 + 512); }
__device__ __forceinline__ s16x4 vtr(lds_cptr p) { return __builtin_bit_cast(s16x4, __builtin_amdgcn_ds_read_tr16_b64_v4i16((LAS v4i16_t*)p)); }
#define MX3(a, b, c) __builtin_fmaxf(__builtin_fmaxf((a), (b)), (c))
__device__ __forceinline__ float rowmax(const f32x16& p0, const f32x16& p1) {
    float a = MX3(p0[0], p0[1], p1[0]), b = MX3(p0[2], p0[3], p1[1]); a = MX3(a, p1[2], p1[3]);
#pragma unroll
    for (int r = 4; r < 16; r += 4) { a = MX3(a, p0[r], p0[r + 1]); b = MX3(b, p0[r + 2], p0[r + 3]); a = MX3(a, p1[r], p1[r + 1]); b = MX3(b, p1[r + 2], p1[r + 3]); }
    float m = __builtin_fmaxf(a, b); auto rr = __builtin_amdgcn_permlane32_swap(__float_as_uint(m), __float_as_uint(m), false, false);
    return __builtin_fmaxf(__uint_as_float(rr[0]), __uint_as_float(rr[1]));
}
__device__ __forceinline__ void pv(f32x16* o, int vb, bf16x8 pa0, bf16x8 pa1, bf16x8 pa2, bf16x8 pa3) {
#pragma unroll
    for (int d0 = 0; d0 < 2; ++d0) { s16x4 lo[4], hi[4];
#pragma unroll
        for (int ks = 0; ks < 4; ++ks) {
            asm volatile("ds_read_b64_tr_b16 %0,%1 offset:%c2" : "=&v"(lo[ks]) : "v"(vb), "i"(d0 * 4096 + ks * 1024) : "memory");
            asm volatile("ds_read_b64_tr_b16 %0,%1 offset:%c2" : "=&v"(hi[ks]) : "v"(vb), "i"(d0 * 4096 + ks * 1024 + 512) : "memory"); }
        asm volatile("s_waitcnt lgkmcnt(0)" ::: "memory"); SBAR();
#define PK(k) (bf16x8){lo[k][0], lo[k][1], lo[k][2], lo[k][3], hi[k][0], hi[k][1], hi[k][2], hi[k][3]}
        o[d0] = __builtin_amdgcn_mfma_f32_32x32x16_bf16(pa0, PK(0), o[d0], 0, 0, 0);
        o[d0] = __builtin_amdgcn_mfma_f32_32x32x16_bf16(pa1, PK(1), o[d0], 0, 0, 0);
        o[d0] = __builtin_amdgcn_mfma_f32_32x32x16_bf16(pa2, PK(2), o[d0], 0, 0, 0);
        o[d0] = __builtin_amdgcn_mfma_f32_32x32x16_bf16(pa3, PK(3), o[d0], 0, 0, 0);
#undef PK
    }
}

template <bool FOX, int THRL, int qp, int kp, int vp, int op>
__device__ __forceinline__ void attn_unit(const bf16* Q, const bf16* __restrict__ K, const bf16* __restrict__ V, bf16* O, int NT, char* shm) {
    int tid = threadIdx.x; asm volatile("" : "+v"(tid));
    const int lane = tid & 63, r32 = lane & 31, hi = lane >> 5; const int wid = __builtin_amdgcn_readfirstlane(tid >> 6);
    const bf16* Qw = Q + (long)(wid * QBLK) * qp;
    const unsigned lds0 = (unsigned)(uintptr_t)shm;
    float* wsf = (float*)(shm + LDS_WS) + wid * 64;
    const bf16* ksrc = K + (long)lane * kp + wid * 8;
    const bf16* vsrc = V + (long)(16 * (wid & 3) + (lane >> 2)) * vp + (wid >> 2) * 32 + (lane & 3) * 8;
    const unsigned kdst = lds0 + LDS_K + wid * 1024, vdst = lds0 + LDS_V + wid * 1024;
#define DMA_K(t, slot) glds16(ksrc + (long)(t) * KVBLK * kp, (unsigned)__builtin_amdgcn_readfirstlane(kdst + (slot)))
#define DMA_V(t, slot) glds16(vsrc + (long)(t) * KVBLK * vp, (unsigned)__builtin_amdgcn_readfirstlane(vdst + (slot)))
    const int vb0 = (int)(lds0 + LDS_V) + ((lane >> 4) & 1) * 32 + (lane & 3) * 8 + (4 * hi + ((lane & 15) >> 2)) * 64;
    const char* Kbase = shm + LDS_K; bf16x8 kf[8];
    const lds_cptr shm3 = (lds_cptr)shm; const lds_cptr kp0 = shm3 + LDS_K + hi * 1024 + r32 * 16; const lds_cptr vp0 = shm3 + LDS_V + ((lane >> 4) & 1) * 32 + (lane & 3) * 8 + (4 * hi + ((lane & 15) >> 2)) * 64;
    const LAS float* biasL = (const LAS float*)(shm3 + LDS_BIAS) + 4 * hi;
    DMA_K(0, 0); DMA_V(0, 0); DMA_K(1, SLOTB);
    bf16x8 qr[4];
#pragma unroll
    for (int d0 = 0; d0 < 4; ++d0) qr[d0] = *reinterpret_cast<const bf16x8*>(&Qw[(long)r32 * qp + d0 * 16 + hi * 8]);
    const int qrel = wid * QBLK + r32;
    float mhat = 0.f, l_reg = 0.f; f32x16 o[2]; o[0] = f32x16{}; o[1] = f32x16{};
    float sq = 0.f;
    if (FOX) sq = -((const LAS float*)(shm3 + LDS_BIAS))[(NT - 4) * KVBLK + qrel];
    bool resc = false;
#define CINIT(C0, C1, t) do { if (FOX) { const LAS float* bp_ = biasL + (t) * KVBLK; \
        _Pragma("unroll") for (int a_ = 0; a_ < 4; ++a_) { const f32x4 b0_ = *(const LAS f32x4*)(bp_ + 8 * a_), b1_ = *(const LAS f32x4*)(bp_ + 32 + 8 * a_); \
            _Pragma("unroll") for (int e_ = 0; e_ < 4; ++e_) { C0[4 * a_ + e_] = b0_[e_] + sq; C1[4 * a_ + e_] = b1_[e_] + sq; } } } \
      else { _Pragma("unroll") for (int r_ = 0; r_ < 16; ++r_) { C0[r_] = sq; C1[r_] = sq; } } } while (0)
#define DECIDE(C0, C1) do { float rm = rowmax(C0, C1); resc = false; \
      if (__builtin_expect(__any(rm > (float)THRL), 0)) { const float dl = __builtin_fmaxf(rm, 0.f); mhat += dl; sq -= dl; \
        _Pragma("unroll") for (int r = 0; r < 16; ++r) { C0[r] -= dl; C1[r] -= dl; } \
        const float f = __builtin_amdgcn_exp2f(-dl); l_reg *= f; if (hi == 0) wsf[r32] = f; resc = true; } } while (0)
#define RESC() do { if (resc) { asm volatile("s_waitcnt lgkmcnt(0)" ::: "memory"); \
      _Pragma("unroll") for (int d_ = 0; d_ < 2; ++d_) _Pragma("unroll") for (int r = 0; r < 16; ++r) o[d_][r] *= wsf[crow(r, hi)]; } } while (0)
#define CMASK(P0, P1, t) do { if (FOX) { int jb_ = (t) - (NT - 4); if (jb_ >= 0) cmask(P0, P1, jb_, qrel, hi); } } while (0)
    f32x16 pA0, pA1, pB0, pB1;
    int sl_prev = 0, sl_cur = 0, sl_next = SLOTB;
#define ROT() do { sl_prev = sl_cur; sl_cur = sl_next; sl_next = (sl_next == (NSLOT - 1) * SLOTB) ? 0 : sl_next + SLOTB; } while (0)
    DMA_K(2, 2 * SLOTB);
    WAIT_BAR(3);
    CINIT(pA0, pA1, 0);
    {
        const char* kb = Kbase + hi * 1024 + r32 * 16;
#pragma unroll
        for (int d0 = 0; d0 < 4; ++d0) {
            const bf16x8 b0 = *reinterpret_cast<const bf16x8*>(kb + d0 * 2048);
            const bf16x8 b1 = *reinterpret_cast<const bf16x8*>(kb + d0 * 2048 + 512);
            pA0 = __builtin_amdgcn_mfma_f32_32x32x16_bf16(b0, qr[d0], pA0, 0, 0, 0); pA1 = __builtin_amdgcn_mfma_f32_32x32x16_bf16(b1, qr[d0], pA1, 0, 0, 0); }
    }
    CMASK(pA0, pA1, 0);
    DECIDE(pA0, pA1);
#pragma unroll
    for (int r = 0; r < 16; ++r) { pA0[r] = __builtin_amdgcn_exp2f(pA0[r]); pA1[r] = __builtin_amdgcn_exp2f(pA1[r]); }
    WAIT_BAR(0);
    DMA_K(3, 0); DMA_V(1, SLOTB);
    ROT();
    kload8(kf, kp0 + sl_cur);
    WAIT_BAR(2);
    s16x4 vlo[8], vhi[8]; u32x4 pw0, pw1, pw2, pw3;
#define PKW(P, B) pk2(P[B], P[B + 1])
#define PAF(k) __builtin_bit_cast(bf16x8, pw##k)
#define VFR(i) (bf16x8){vlo[i][0], vlo[i][1], vlo[i][2], vlo[i][3], vhi[i][0], vhi[i][1], vhi[i][2], vhi[i][3]}
#define PIN(x) asm volatile("" : "+v"(x))
#define GAPA(MF, A0, A1, A2, A3, W0, W1, PW) do { MF; sacc += A0; sacc += A1; sacc += A2; sacc += A3; PIN(sacc); W0; W1; PIN(PW); SBAR(); } while (0)
#define EX(v) __builtin_amdgcn_exp2f(v)
#define GAPB(MF, X, B) do { MF; X[B] = EX(X[B]); X[B + 1] = EX(X[B + 1]); X[B + 2] = EX(X[B + 2]); X[B + 3] = EX(X[B + 3]); PIN(X); SBAR(); } while (0)
#define VRD(i) do { vlo[i] = vtr(vp_ + (((i) >> 2) * 4096 + ((i) & 3) * 1024)); vhi[i] = vtr(vp_ + (((i) >> 2) * 4096 + ((i) & 3) * 1024 + 512)); } while (0)
#define KRD(G, j) do { if (G) { kload2(kf, kp0 + sl_next, j); SBAR(); } } while (0)
#define STEP(C0, C1, P0, P1, t, GK, GV, GL) do { SBAR(); \
    const lds_cptr vp_ = vp0 + sl_prev; \
    CINIT(C0, C1, t); SBAR(); \
    VRD(0); SBAR(); float sacc = (P0[0] + P0[1]); \
    GAPA(C0 = __builtin_amdgcn_mfma_f32_32x32x16_bf16(kf[0], qr[0], C0, 0, 0, 0), P0[2], P0[3], P0[4], P0[5],     pw0[0] = PKW(P0, 0), pw0[1] = PKW(P0, 2), pw0); \
    VRD(4); SBAR(); GAPA(C1 = __builtin_amdgcn_mfma_f32_32x32x16_bf16(kf[1], qr[0], C1, 0, 0, 0), P0[6], P0[7], P0[8], P0[9],     pw0[2] = PKW(P0, 4), pw0[3] = PKW(P0, 6), pw0); \
    VRD(1); SBAR(); GAPA(C0 = __builtin_amdgcn_mfma_f32_32x32x16_bf16(kf[2], qr[1], C0, 0, 0, 0),   P0[10], P0[11], P0[12], P0[13], pw1[0] = PKW(P0, 8), pw1[1] = PKW(P0, 10), pw1); \
    VRD(5); SBAR(); GAPA(C1 = __builtin_amdgcn_mfma_f32_32x32x16_bf16(kf[3], qr[1], C1, 0, 0, 0),   P0[14], P0[15], P1[0], P1[1],   pw1[2] = PKW(P0, 12), pw1[3] = PKW(P0, 14), pw1); \
    VRD(2); SBAR(); GAPA(C0 = __builtin_amdgcn_mfma_f32_32x32x16_bf16(kf[4], qr[2], C0, 0, 0, 0),   P1[2], P1[3], P1[4], P1[5],     pw2[0] = PKW(P1, 0), pw2[1] = PKW(P1, 2), pw2); \
    VRD(6); SBAR(); GAPA(C1 = __builtin_amdgcn_mfma_f32_32x32x16_bf16(kf[5], qr[2], C1, 0, 0, 0),   P1[6], P1[7], P1[8], P1[9],     pw2[2] = PKW(P1, 4), pw2[3] = PKW(P1, 6), pw2); \
    VRD(3); SBAR(); GAPA(C0 = __builtin_amdgcn_mfma_f32_32x32x16_bf16(kf[6], qr[3], C0, 0, 0, 0),   P1[10], P1[11], P1[12], P1[13], pw3[0] = PKW(P1, 8), pw3[1] = PKW(P1, 10), pw3); \
    VRD(7); SBAR(); GAPA(C1 = __builtin_amdgcn_mfma_f32_32x32x16_bf16(kf[7], qr[3], C1, 0, 0, 0),   P1[14], P1[15], 0.f, 0.f,       pw3[2] = PKW(P1, 12), pw3[3] = PKW(P1, 14), pw3); \
    l_reg += sacc; \
    if (GK) { DMA_K((t) + 3, sl_cur); } if (GV) { DMA_V((t) + 1, sl_next); } \
    CMASK(C0, C1, t); \
    DECIDE(C0, C1); \
    SBAR(); \
    GAPB(o[0] = __builtin_amdgcn_mfma_f32_32x32x16_bf16(PAF(0), VFR(0), o[0], 0, 0, 0), C0, 0); \
    GAPB(o[1] = __builtin_amdgcn_mfma_f32_32x32x16_bf16(PAF(0), VFR(4), o[1], 0, 0, 0), C0, 4); \
    KRD(GL, 0); GAPB(o[0] = __builtin_amdgcn_mfma_f32_32x32x16_bf16(PAF(1), VFR(1), o[0], 0, 0, 0), C0, 8); \
    KRD(GL, 1); GAPB(o[1] = __builtin_amdgcn_mfma_f32_32x32x16_bf16(PAF(1), VFR(5), o[1], 0, 0, 0), C0, 12); \
    KRD(GL, 2); GAPB(o[0] = __builtin_amdgcn_mfma_f32_32x32x16_bf16(PAF(2), VFR(2), o[0], 0, 0, 0), C1, 0); \
    KRD(GL, 3); GAPB(o[1] = __builtin_amdgcn_mfma_f32_32x32x16_bf16(PAF(2), VFR(6), o[1], 0, 0, 0), C1, 4); \
    GAPB(o[0] = __builtin_amdgcn_mfma_f32_32x32x16_bf16(PAF(3), VFR(3), o[0], 0, 0, 0), C1, 8); \
    GAPB(o[1] = __builtin_amdgcn_mfma_f32_32x32x16_bf16(PAF(3), VFR(7), o[1], 0, 0, 0), C1, 12); \
    } while (0)
    int t = 1;
    for (; t + 5 < NT; t += 2) {
        STEP(pB0, pB1, pA0, pA1, t, true, true, true);     WAIT_BAR(2); RESC(); ROT();
        STEP(pA0, pA1, pB0, pB1, t + 1, true, true, true); WAIT_BAR(2); RESC(); ROT();
    }
#define ENDW(tt) do { if ((tt) + 3 < NT) { WAIT_BAR(2); } else if ((tt) + 2 < NT) { WAIT_BAR(1); } else { WAIT_BAR(0); } } while (0)
    for (; t + 1 < NT; t += 2) {
        STEP(pB0, pB1, pA0, pA1, t, (t + 3 < NT), (t + 1 < NT), (t + 1 < NT));       ENDW(t);     RESC(); ROT();
        STEP(pA0, pA1, pB0, pB1, t + 1, (t + 4 < NT), (t + 2 < NT), (t + 2 < NT));   ENDW(t + 1); RESC(); ROT();
    }
    STEP(pB0, pB1, pA0, pA1, NT - 1, false, false, false); RESC();
    { float sacc = pB0[0] + pB0[1];
#pragma unroll
      for (int r = 2; r < 16; ++r) sacc += pB0[r];
#pragma unroll
      for (int r = 0; r < 16; ++r) sacc += pB1[r];
      l_reg += sacc;
      pw0 = (u32x4){PKW(pB0, 0), PKW(pB0, 2), PKW(pB0, 4), PKW(pB0, 6)}; pw1 = (u32x4){PKW(pB0, 8), PKW(pB0, 10), PKW(pB0, 12), PKW(pB0, 14)};
      pw2 = (u32x4){PKW(pB1, 0), PKW(pB1, 2), PKW(pB1, 4), PKW(pB1, 6)}; pw3 = (u32x4){PKW(pB1, 8), PKW(pB1, 10), PKW(pB1, 12), PKW(pB1, 14)};
      SBAR(); pv(o, vb0 + sl_cur, PAF(0), PAF(1), PAF(2), PAF(3)); }
    { auto rr = __builtin_amdgcn_permlane32_swap(__float_as_uint(l_reg), __float_as_uint(l_reg), false, false); l_reg = __uint_as_float(rr[0]) + __uint_as_float(rr[1]); }
    if (hi == 0) wsf[32 + r32] = l_reg; asm volatile("s_waitcnt lgkmcnt(0)" ::: "memory");
    float rli[16];
#pragma unroll
    for (int r = 0; r < 16; ++r) rli[r] = __builtin_amdgcn_rcpf(wsf[32 + crow(r, hi)]);
    bf16* Ow = O + (long)(wid * QBLK) * op;
    { bf16* stg = (bf16*)(shm + LDS_OST) + wid * 2048;
#pragma unroll
      for (int r = 0; r < 16; ++r) { const int orow = crow(r, hi);
#pragma unroll
          for (int d0 = 0; d0 < 2; ++d0) stg[orow * 64 + d0 * 32 + r32] = __float2bfloat16(o[d0][r] * rli[r]); }
      asm volatile("s_waitcnt lgkmcnt(0)" ::: "memory");
#pragma unroll
      for (int i = 0; i < 4; ++i) { const int row = i * 8 + (lane >> 3), ch = lane & 7; const u32x4 v = *(const u32x4*)(stg + row * 64 + ch * 8); *(u32x4*)(Ow + (long)row * op + ch * 8) = v; } }
    asm volatile("s_waitcnt lgkmcnt(0)\n\ts_barrier" ::: "memory");
#undef DMA_K
#undef DMA_V
#undef CINIT
#undef DECIDE
#undef RESC
#undef CMASK
#undef ROT
#undef PKW
#undef PAF
#undef VFR
#undef PIN
#undef GAPA
#undef GAPB
#undef EX
#undef VRD
#undef KRD
#undef STEP
#undef ENDW
}

__device__ __forceinline__ void bias_scan(const float* lf, int n, char* shm) {
    int tid = threadIdx.x; asm volatile("" : "+v"(tid));
    const int lane = tid & 63, wid = tid >> 6;
    LAS float* bias = (LAS float*)((lds_cptr)shm + LDS_BIAS); LAS float* wtot = (LAS float*)((lds_cptr)shm + LDS_WTOT);
    f32x4 v = (f32x4){0.f, 0.f, 0.f, 0.f};
    if (4 * tid < n) v = *(const f32x4*)(lf + 4 * tid);
    v[1] += v[0]; v[2] += v[1]; v[3] += v[2];
    float s = v[3];
#pragma unroll
    for (int o = 1; o < 64; o <<= 1) { const float u = __shfl_up(s, o); if (lane >= o) s += u; }
    if (lane == 63) wtot[wid] = s;
    __syncthreads();
    float base = s - v[3];
    for (int w = 0; w < wid; ++w) base += wtot[w];
    if (4 * tid < n) { f32x4 r; r[0] = -(base + v[0]) * LOG2E; r[1] = -(base + v[1]) * LOG2E; r[2] = -(base + v[2]) * LOG2E; r[3] = -(base + v[3]) * LOG2E; *(LAS f32x4*)(bias + 4 * tid) = r; }
    __syncthreads();
}
#undef SBAR
#undef WAIT_BAR
#undef MX3
}

constexpr int GM_VSTRIDE = 416;
constexpr int GM_RSTD_OFF = 128 * GM_VSTRIDE;
__device__ __forceinline__ void gmlp_unit(int b, int n, int g, const bf16_t* z, const float* vssp, const float* w_s, const float* b_s, const float* vgain, bf16_t* mix, char* shm) {
    typedef __attribute__((address_space(3))) char* lds_ptr;
    int tid = threadIdx.x; asm volatile("" : "+v"(tid));
    const int lane = tid & 63, fr = lane & 15, fq = lane >> 4; const int wid = __builtin_amdgcn_readfirstlane(tid >> 6);
    const int t0 = b * SEQ + n * 128;
    lds_ptr sh = (lds_ptr)shm; LAS float* rstd = (LAS float*)(sh + GM_RSTD_OFF);
#pragma unroll
    for (int i = 0; i < 6; ++i) { const int idx = tid + NTHR * i, row = idx / 24, ch = idx % 24;
        const u32x4 w = *(const u32x4*)(z + (size_t)(t0 + row) * ZW + TOK + 192 * g + ch * 8);
        const int p = ch >> 2, a = ch & 3; lds_ptr dst = sh + row * GM_VSTRIDE + p * 64 + a * 8;
        *(LAS u32x2*)(dst) = (u32x2){w.x, w.y}; *(LAS u32x2*)(dst + 32) = (u32x2){w.z, w.w}; }
    if (tid < 128) { const float* p = vssp + (size_t)(t0 + tid) * 12; float s = 0.f;
#pragma unroll
        for (int i = 0; i < 12; ++i) s += p[i];
        rstd[tid] = rsqrtf(s * (1.0f / TOK) + EPS); }
    __syncthreads();
    f32x4 acc[12];
#pragma unroll
    for (int i = 0; i < 12; ++i) acc[i] = (f32x4){0.f, 0.f, 0.f, 0.f};
    const int trow = 16 * wid + fr;
    const int nks = (wid >> 1) + 1;
    const float* wrow = w_s + ((size_t)g * 128 + trow) * 128;
    for (int ks = 0; ks < nks; ++ks) {
        const int s0 = 32 * ks + 4 * fq;
        const f32x4 w0 = *(const f32x4*)(wrow + s0), w1 = *(const f32x4*)(wrow + s0 + 16);
        const f32x4 r0 = *(const LAS f32x4*)(rstd + s0), r1 = *(const LAS f32x4*)(rstd + s0 + 16);
        float wv[8];
#pragma unroll
        for (int e = 0; e < 4; ++e) { wv[e] = (s0 + e <= trow) ? w0[e] * r0[e] : 0.f; wv[4 + e] = (s0 + 16 + e <= trow) ? w1[e] * r1[e] : 0.f; }
        u32x4 wp; wp.x = pk2(wv[0], wv[1]); wp.y = pk2(wv[2], wv[3]); wp.z = pk2(wv[4], wv[5]); wp.w = pk2(wv[6], wv[7]);
        const bf16x8 wfrag = __builtin_bit_cast(bf16x8, wp);
        lds_ptr vbase = sh + (32 * ks + 4 * fq + (fr >> 2)) * GM_VSTRIDE + (fr & 3) * 8;
#pragma unroll
        for (int nb = 0; nb < 12; ++nb) {
            const s16x4 lo = __builtin_bit_cast(s16x4, __builtin_amdgcn_ds_read_tr16_b64_v4i16((LAS attn_body::v4i16_t*)(vbase + (nb >> 1) * 64 + (nb & 1) * 32)));
            const s16x4 hi = __builtin_bit_cast(s16x4, __builtin_amdgcn_ds_read_tr16_b64_v4i16((LAS attn_body::v4i16_t*)(vbase + 16 * GM_VSTRIDE + (nb >> 1) * 64 + (nb & 1) * 32)));
            const bf16x8 vfrag = (bf16x8){lo[0], lo[1], lo[2], lo[3], hi[0], hi[1], hi[2], hi[3]};
            acc[nb] = __builtin_amdgcn_mfma_f32_16x16x32_bf16(vfrag, wfrag, acc[nb], 0, 0, 0);
        }
    }
    const float bs = b_s[g * 128 + trow];
    const size_t rowoff = (size_t)(t0 + trow);
#pragma unroll
    for (int p = 0; p < 6; ++p) {
        const int c0 = 192 * g + 32 * p + 8 * fq;
        const f32x4 g0 = *(const f32x4*)(vgain + c0), g1 = *(const f32x4*)(vgain + c0 + 4);
        const u32x4 uu = *(const u32x4*)(z + rowoff * ZW + c0);
        f32x4 m0 = acc[2 * p] * g0 + bs, m1 = acc[2 * p + 1] * g1 + bs;
        u32x4 w; w.x = pk2(bf_lo(uu.x) * m0[0], bf_hi(uu.x) * m0[1]); w.y = pk2(bf_lo(uu.y) * m0[2], bf_hi(uu.y) * m0[3]);
        w.z = pk2(bf_lo(uu.z) * m1[0], bf_hi(uu.z) * m1[1]); w.w = pk2(bf_lo(uu.w) * m1[2], bf_hi(uu.w) * m1[3]);
        *(u32x4*)(mix + rowoff * D + c0) = w;
    }
    __syncthreads();
}

constexpr int N_PHASES = 12;
#ifndef MK_REP_PHASE
#define MK_REP_PHASE 0
#endif
#ifndef MK_DBG_PTR
#define MK_DBG_PTR nullptr
#endif
struct Args { const float* in[29]; float* out; unsigned char* ws; int ph_lo, ph_hi, rep, pad; };

__global__ void __launch_bounds__(NTHR, 2) mk_fwd(Args args) {
    extern __shared__ __attribute__((aligned(16))) unsigned char lds[];
    LAS unsigned char* L = (LAS unsigned char*)lds;
    volatile LAS unsigned* MISC = (volatile LAS unsigned*)(L + MISC_OFF);
    const int tid = threadIdx.x, lane = tid & 63, wave = __builtin_amdgcn_readfirstlane(tid >> 6);
    const int G = gridDim.x; const int bx = blockIdx.x; const int vcu = (G % 8 == 0) ? (bx % 8) * (G / 8) + bx / 8 : bx;
    unsigned char* ws = args.ws;
#define in args.in
#define xf args.out
#define P_BF(off) ((bf16_t*)(ws + (off)))
#define P_F32(off) ((float*)(ws + (off)))
#define Win P_BF(WS_WIN)
#define Wmem P_BF(WS_WMEM)
#define AWout P_BF(WS_AWOUT)
#define Affi P_BF(WS_AFFI)
#define Affo P_BF(WS_AFFO)
#define Kvq P_BF(WS_KVQ)
#define BWout P_BF(WS_BWOUT)
#define Bffi P_BF(WS_BFFI)
#define Bffo P_BF(WS_BFFO)
#define xb P_BF(WS_XB)
#define mix P_BF(WS_MIX)
#define memb P_BF(WS_MEMB)
#define memkv P_BF(WS_MEMKV)
#define qmem P_BF(WS_QMEM)
#define ss4 P_F32(WS_SS4)
#define memss P_F32(WS_MEMSS)
#define vssp P_F32(WS_VSSP)
#define lf P_F32(WS_LF)
#define halo P_F32(WS_HALO)
#define zb P_BF(WS_R1)
#define gb P_BF(WS_R1)
#define kb P_BF(WS_KB)
#define vb P_BF(WS_VB)
#define qb P_BF(WS_QB)
    if (tid < 64) ((LAS unsigned*)(L + MISC_OFF))[tid] = 0u;
    __syncthreads();
    const int lo = args.ph_lo, hi = args.ph_hi;
    const bool use_bar = (hi - lo) > 1;
    XcdBarrier bar; bar.bar = (unsigned*)(ws + WS_CTL) + 4096; bar.x = 0; bar.st = nullptr;
    if (use_bar) bar = xcd_barrier_post((unsigned*)(ws + WS_CTL) + 4096, MISC + 8);
#define IN(k) (lo <= (k) && (k) < hi)
#if MK_REP_PHASE
#define REPS(k) for (int rep_ = 0; rep_ < (IN(k) ? (((args.rep >> (k)) & 1) ? 2 : 1) : 0); ++rep_)
#else
#define REPS(k) if (IN(k))
#endif
#define SEAM(k) do { if (IN(k) && IN((k) + 1)) xcd_barrier(bar); } while (0)

    REPS(0) {
        const int gw = vcu * NWAVES + wave, NGW = G * NWAVES;
        convert_items(IT0_WIN, IT_WIN + IT_WMEM, gw, NGW, in, ws, (LAS float*)(L + wave * 16384), lane);
        for (int m = 2 * gw; m < M; m += 2 * NGW) rows2_to_bf16(in[0] + (size_t)m * D, xb + (size_t)m * D, ss4 + (size_t)m * 4, lane);
        for (int m = 2 * gw; m < MROWS; m += 2 * NGW) rows2_to_bf16(in[1] + (size_t)m * D, memb + (size_t)m * D, memss + (size_t)m * 4, lane);
    }
    SEAM(0);
    REPS(1) {
        pg8::Sched S; S.init(M, ZW, D, G, bx, xb, Win); S.extra(MROWS, 1024, memb, Wmem);
        pg8::EpiIn E{zb, memkv, qmem, ss4, memss, vssp};
        pg8::gemm_phase<pg8::EpiIn, true, false>(L, S, E);
        if (G == 256 && bx >= 224) convert_items(IT0_AWOUT, IT_WOUT + 1792, (bx - 224) * NWAVES + wave, 32 * NWAVES, in, ws, (LAS float*)(L + wave * 16384), lane);
    }
    SEAM(1);
    REPS(2) {
        if (G == 256) convert_items(IT0_AFFI + 1792, IT_FFI - 1792, vcu * NWAVES + wave, G * NWAVES, in, ws, (LAS float*)(L + wave * 16384), lane);
        else convert_items(IT0_AWOUT, IT_WOUT + IT_FFI, vcu * NWAVES + wave, G * NWAVES, in, ws, (LAS float*)(L + wave * 16384), lane);
        __syncthreads();
        for (int uidx = vcu; uidx < 512; uidx += G) gmlp_unit(uidx >> 6, (uidx >> 2) & 15, uidx & 3, zb, vssp, in[5], in[6], in[4], mix, (char*)lds);
        for (int uidx = vcu; uidx < 256; uidx += G) { const int b = uidx >> 5, h = (uidx >> 3) & 3, qt = uidx & 7;
            const size_t row0 = (size_t)b * SEQ + qt * 256;
            attn_body::attn_unit<false, 8, MEMW, 1024, 1024, D>((const attn_body::bf16*)qmem + row0 * MEMW + 64 * h, (const attn_body::bf16*)memkv + (size_t)b * NMEM * 1024 + 64 * h,
                                           (const attn_body::bf16*)memkv + (size_t)b * NMEM * 1024 + 256 + 64 * h, (attn_body::bf16*)mix + row0 * D + TOK + 64 * h, 4, (char*)lds); }
    }
    SEAM(2);
    REPS(3) {
        pg8::Sched S; S.init(M, D, D, G, bx, mix, AWout);
        pg8::EpiRes<true, false> E{in[0], xf, xb, ss4};
        pg8::gemm_phase<pg8::EpiRes<true, false>, false, false>(L, S, E);
    }
    SEAM(3);
    REPS(4) {
        pg8::Sched S; S.init(M, 2 * DFF, D, G, bx, xb, Affi);
        pg8::EpiFfn E{gb, halo, ss4, in[12], in[13]};
        pg8::gemm_phase<pg8::EpiFfn, true, true>(L, S, E);
        if (G == 256) { if (bx >= 128) convert_items(IT0_AFFO, IT_TOTAL - IT0_AFFO, (bx - 128) * NWAVES + wave, 128 * NWAVES, in, ws, (LAS float*)(L + wave * 16384), lane); }
        else convert_items(IT0_AFFO, IT_TOTAL - IT0_AFFO, vcu * NWAVES + wave, G * NWAVES, in, ws, (LAS float*)(L + wave * 16384), lane);
    }
    SEAM(4);
    if (IN(5)) {
        pg8::Sched S; S.init(M, D, DFF, G, bx, gb, Affo);
        { pg8::Unit u0; if (S.next(0, u0)) fixup_panel(u0.pm, gb, halo, in[12], in[13]); }
        pg8::EpiRes<false, false> E{nullptr, xf, xb, ss4};
        pg8::gemm_phase<pg8::EpiRes<false, false>, false, false>(L, S, E);
    }
    SEAM(5);
    REPS(6) {
        pg8::Sched S; S.init(M, 2816, D, G, bx, xb, Kvq);
        pg8::EpiKvq E{kb, vb, qb, qmem, lf, ss4, in[17]};
        pg8::gemm_phase<pg8::EpiKvq, true, false>(L, S, E);
    }
    SEAM(6);
    REPS(7) {
        for (int v = vcu; v < 256; v += G) {
            const int grp = v >> 3, k8 = v & 7;
            const unsigned tbe = k8 == 0 ? 0x000c1cu : k8 == 1 ? 0x040d1du : k8 == 2 ? 0x05081eu : k8 == 3 ? 0x011018u : k8 == 4 ? 0x021419u : k8 == 5 ? 0x06111au : k8 == 6 ? 0x091215u : 0x0a0e16u;
#pragma unroll 1
            for (int i = 0; i < 3; ++i) {
                const unsigned e = (tbe >> (8 * i)) & 0xffu; const int qb_ = (int)(e >> 2), cp = (int)(e & 3u);
                const int bh = grp * 3 + cp, b = bh / NFOX, h = bh % NFOX;
                const int NT = 4 * qb_ + 4; const size_t rowb = (size_t)b * SEQ, row0 = rowb + qb_ * 256;
                attn_body::bias_scan(lf + ((size_t)b * NFOX + h) * SEQ, NT * 64, (char*)lds);
                attn_body::attn_unit<true, 8, KVW, KVW, KVW, D>((const attn_body::bf16*)qb + row0 * KVW + 64 * h, (const attn_body::bf16*)kb + rowb * KVW + 64 * h,
                                              (const attn_body::bf16*)vb + rowb * KVW + 64 * h, (attn_body::bf16*)mix + row0 * D + 64 * h, NT, (char*)lds);
            }
        }
        for (int uidx = vcu; uidx < 256; uidx += G) { const int b = uidx >> 5, h = (uidx >> 3) & 3, qt = uidx & 7;
            const size_t row0 = (size_t)b * SEQ + qt * 256;
            attn_body::attn_unit<false, 8, MEMW, 1024, 1024, D>((const attn_body::bf16*)qmem + row0 * MEMW + 64 * h, (const attn_body::bf16*)memkv + (size_t)b * NMEM * 1024 + 512 + 64 * h,
                                           (const attn_body::bf16*)memkv + (size_t)b * NMEM * 1024 + 768 + 64 * h, (attn_body::bf16*)mix + row0 * D + TOK + 64 * h, 4, (char*)lds); }
    }
    SEAM(7);
    if (IN(8)) {
        pg8::Sched S; S.init(M, D, D, G, bx, mix, BWout);
        pg8::EpiRes<false, false> E{nullptr, xf, xb, ss4};
        pg8::gemm_phase<pg8::EpiRes<false, false>, false, false>(L, S, E);
    }
    SEAM(8);
    if (IN(9)) {
        pg8::Sched S; S.init(M, 2 * DFF, D, G, bx, xb, Bffi);
        pg8::EpiFfn E{gb, halo, ss4, in[25], in[26]};
        pg8::gemm_phase<pg8::EpiFfn, true, true>(L, S, E);
    }
    SEAM(9);
    if (IN(10)) {
        pg8::Sched S; S.init(M, D, DFF, G, bx, gb, Bffo);
        { pg8::Unit u0; if (S.next(0, u0)) fixup_panel(u0.pm, gb, halo, in[25], in[26]); }
        pg8::EpiRes<false, true> E{nullptr, xf, xb, ss4};
        pg8::gemm_phase<pg8::EpiRes<false, true>, false, false>(L, S, E);
    }
    SEAM(10);
    if (IN(11)) final_phase(vcu, G, wave, lane, xf, ss4, in[28]);
#undef IN
#undef REPS
#undef SEAM
#undef in
#undef xf
#undef Win
#undef Wmem
#undef AWout
#undef Affi
#undef Affo
#undef Kvq
#undef BWout
#undef Bffi
#undef Bffo
#undef xb
#undef mix
#undef memb
#undef memkv
#undef qmem
#undef ss4
#undef memss
#undef vssp
#undef lf
#undef halo
#undef zb
#undef gb
#undef kb
#undef vb
#undef qb
}

#ifndef MK_N_LAUNCHES
#define MK_N_LAUNCHES 1
#endif
static int mk_grid() {
    static int grid = 0;
    if (grid == 0) {
        int dev = 0, cus = 0, per_cu = 0;
        if (hipGetDevice(&dev) != hipSuccess || hipDeviceGetAttribute(&cus, hipDeviceAttributeMultiprocessorCount, dev) != hipSuccess) { fprintf(stderr, "kernel_launch: device query failed\n"); grid = -1; return grid; }
        if (hipFuncSetAttribute((const void*)mk_fwd, hipFuncAttributeMaxDynamicSharedMemorySize, LDS_BYTES) != hipSuccess) { fprintf(stderr, "kernel_launch: hipFuncSetAttribute failed\n"); grid = -1; return grid; }
        if (hipOccupancyMaxActiveBlocksPerMultiprocessor(&per_cu, (const void*)mk_fwd, NTHR, LDS_BYTES) != hipSuccess || per_cu < 1) { fprintf(stderr, "kernel_launch: occupancy query reports %d blocks per CU\n", per_cu); grid = -1; return grid; }
        (void)hipGetLastError();
        grid = cus;
    }
    return grid;
}
static void mk_launch(void* const* d_in, void* d_out, void* d_ws, hipStream_t stream, int nlaunch) {
    const int grid = mk_grid(); if (grid <= 0) return;
    (void)hipMemsetAsync((char*)d_ws + WS_CTL, 0, CTL_ZERO_BYTES, stream);
    Args a{};
    for (int i = 0; i < 29; ++i) a.in[i] = (const float*)d_in[i];
    a.out = (float*)d_out; a.ws = (unsigned char*)d_ws; a.rep = MK_REP_PHASE;
    if (nlaunch == 1) { a.ph_lo = 0; a.ph_hi = N_PHASES; hipLaunchKernelGGL(mk_fwd, dim3(grid), dim3(NTHR), LDS_BYTES, stream, a); }
    else for (int p = 0; p < N_PHASES; ++p) { a.ph_lo = p; a.ph_hi = p + 1; hipLaunchKernelGGL(mk_fwd, dim3(grid), dim3(NTHR), LDS_BYTES, stream, a); }
}

extern "C" void kernel_launch(void* const* d_in, const int* in_sizes, int n_in, void* d_out, int out_size, void* d_ws, size_t ws_size, hipStream_t stream) {
    if (n_in != 29 || out_size != M * D || ws_size < WS_END) { fprintf(stderr, "kernel_launch: unexpected sizes\n"); return; }
    mk_launch(d_in, d_out, d_ws, stream, MK_N_LAUNCHES);
}
```
